# Optimizing an MI355X kernel written in HIP

```python
import jax, jax.numpy as jnp
from jax import lax
import numpy as np

D_MODEL = 1024
BATCH = 4
SEQ = 8192
DEPTH = 1

N_META = 16
EPS = 1e-6
MIX_WIDTH = D_MODEL
CONV_CH = MIX_WIDTH // 2
CONV_HEADS = 8
CONV_WIDTH = 3
POOL_CH = MIX_WIDTH - CONV_CH
POOL_WINDOWS = (2, 4, 8, 16)
N_POOL_GROUPS = len(POOL_WINDOWS)
POOL_GROUP_DIM = POOL_CH // N_POOL_GROUPS
IN_PROJ_COLS = 3 * CONV_CH + POOL_CH

PEER_HEADS = 8
N_KEYS = 128
N_EXPERTS = N_KEYS * N_KEYS
PEER_KEY_DIM = 256
PEER_KEY_HALF = PEER_KEY_DIM // 2
PEER_TOPK = 16
PEER_CHUNK = 128

kernel_name = "hybrid_conv_pool_peer_encoder"


def rms_norm(x, g):
    xf = x.astype(jnp.float32)
    y = xf * lax.rsqrt(jnp.mean(xf * xf, axis=-1, keepdims=True) + EPS)
    return (y * g.astype(jnp.float32)).astype(x.dtype)


def short_gated_conv(h, b_gate, c_gate, conv_w, conv_b):
    L = h.shape[1]
    z = c_gate * h
    zp = jnp.pad(z, ((0, 0), (1, 1), (0, 0)))
    conv = (zp[:, 0:L] * conv_w[0] + zp[:, 1:L + 1] * conv_w[1]
            + zp[:, 2:L + 2] * conv_w[2] + conv_b)
    return b_gate * conv


def multiscale_pool(z, pool_w, pool_scale):
    Bn, L, C = z.shape
    zf = z.astype(jnp.float32).reshape(Bn, L, N_POOL_GROUPS, POOL_GROUP_DIM)
    cs = jnp.concatenate([jnp.zeros_like(zf[:, :1]), jnp.cumsum(zf, axis=1)], axis=1)
    t = np.arange(L)
    avgs = []
    for g, w in enumerate(POOL_WINDOWS):
        hi = np.minimum(t + w // 2, L)
        lo = np.maximum(t - w // 2, 0)
        cs_g = cs[:, :, g]
        s = jnp.take(cs_g, hi, axis=1) - jnp.take(cs_g, lo, axis=1)
        cnt = (hi - lo).astype(np.float32)
        avgs.append(s / cnt[None, :, None])
    avg = jnp.stack(avgs, axis=2)
    mixed = (avg - zf).astype(z.dtype)
    y = jnp.einsum('blgc,gcd->blgd', mixed, pool_w)
    return y.reshape(Bn, L, C) * pool_scale


def peer_ffn(xn, w_q, peer_keys, peer_u, peer_v):
    Bn, L, D = xn.shape
    tok = xn.reshape(-1, D)
    T = tok.shape[0]
    pad = (-T) % PEER_CHUNK
    chunks = jnp.pad(tok, ((0, pad), (0, 0))).reshape(-1, PEER_CHUNK, D)

    def chunk_fn(xc):
        c = xc.shape[0]
        q = (xc @ w_q).reshape(c, PEER_HEADS, 2, PEER_KEY_HALF)
        s = jnp.einsum('chpd,hpnd->chpn', q, peer_keys).astype(jnp.float32)
        sv, si = lax.top_k(s, PEER_TOPK)
        cand = sv[:, :, 0, :, None] + sv[:, :, 1, None, :]
        cand_idx = si[:, :, 0, :, None] * N_KEYS + si[:, :, 1, None, :]
        cand = cand.reshape(c, PEER_HEADS, PEER_TOPK * PEER_TOPK)
        cand_idx = cand_idx.reshape(c, PEER_HEADS, PEER_TOPK * PEER_TOPK)
        top_s, pos = lax.top_k(cand, PEER_TOPK)
        idx = jnp.take_along_axis(cand_idx, pos, axis=-1)
        gate = jax.nn.softmax(top_s, axis=-1)
        u_sel = peer_u[idx]
        v_sel = peer_v[idx]
        act = jax.nn.gelu(jnp.einsum('chkd,cd->chk', u_sel, xc).astype(jnp.float32),
                          approximate=False)
        wts = (gate * act).astype(xc.dtype)
        return jnp.einsum('chk,chkd->cd', wts, v_sel)

    out = lax.map(chunk_fn, chunks)
    return out.reshape(-1, D)[:T].reshape(Bn, L, D)


def setup_inputs(seed: int = 0) -> dict:
    key = jax.random.key(seed)
    ks = jax.random.split(key, 15)
    f32 = jnp.float32
    d = D_MODEL
    return {
        "x": jax.random.normal(ks[0], (BATCH, SEQ, d), f32),
        "meta_tokens": jax.random.normal(ks[1], (N_META, d), f32),
        "norm1_g": 1.0 + 0.02 * jax.random.normal(ks[2], (d,), f32),
        "w_in": jax.random.normal(ks[3], (d, IN_PROJ_COLS), f32) * d ** -0.5,
        "conv_w": jax.random.normal(ks[4], (CONV_WIDTH, CONV_CH), f32) * CONV_WIDTH ** -0.5,
        "conv_b": 0.01 * jax.random.normal(ks[5], (CONV_CH,), f32),
        "pool_w": jax.random.normal(ks[6], (N_POOL_GROUPS, POOL_GROUP_DIM, POOL_GROUP_DIM), f32)
                  * POOL_GROUP_DIM ** -0.5,
        "pool_scale": 1.0 + 0.1 * jax.random.normal(ks[7], (POOL_CH,), f32),
        "w_out": jax.random.normal(ks[8], (MIX_WIDTH, d), f32) * MIX_WIDTH ** -0.5,
        "norm2_g": 1.0 + 0.02 * jax.random.normal(ks[9], (d,), f32),
        "peer_w_q": jax.random.normal(ks[10], (d, PEER_HEADS * PEER_KEY_DIM), f32) * d ** -0.5,
        "peer_keys": jax.random.normal(ks[11], (PEER_HEADS, 2, N_KEYS, PEER_KEY_HALF), f32)
                     * PEER_KEY_HALF ** -0.5,
        "peer_u": jax.random.normal(ks[12], (N_EXPERTS, d), f32) * d ** -0.5,
        "peer_v": jax.random.normal(ks[13], (N_EXPERTS, d), f32) * PEER_HEADS ** -0.5,
        "final_norm_g": 1.0 + 0.02 * jax.random.normal(ks[14], (d,), f32),
    }


def reference(x, meta_tokens, norm1_g, w_in, conv_w, conv_b, pool_w, pool_scale, w_out,
              norm2_g, peer_w_q, peer_keys, peer_u, peer_v, final_norm_g):
    Bn = x.shape[0]
    meta = jnp.broadcast_to(meta_tokens.astype(x.dtype)[None], (Bn, N_META, D_MODEL))
    h = jnp.concatenate([meta, x], axis=1)

    for _ in range(DEPTH):
        hn = rms_norm(h, norm1_g)
        p = hn @ w_in
        hA = p[..., 0:CONV_CH]
        b_gate = p[..., CONV_CH:2 * CONV_CH]
        c_gate = p[..., 2 * CONV_CH:3 * CONV_CH]
        hB = p[..., 3 * CONV_CH:]
        yA = short_gated_conv(hA, b_gate, c_gate, conv_w, conv_b)
        yB = multiscale_pool(hB, pool_w, pool_scale)
        h = h + jnp.concatenate([yA, yB], axis=-1) @ w_out
        h = h + peer_ffn(rms_norm(h, norm2_g), peer_w_q, peer_keys, peer_u, peer_v)

    out = rms_norm(h, final_norm_g)
    return out[:, N_META:]
```

```cpp
#include <hip/hip_runtime.h>
#include <cstdio>
#include <cstdint>
namespace pg8 {
#define PG8_LAS __attribute__((address_space(3)))
typedef unsigned short bf16_t;
typedef short bf16x8 __attribute__((ext_vector_type(8)));
typedef float f32x4 __attribute__((ext_vector_type(4)));
typedef unsigned u32x4 __attribute__((ext_vector_type(4)));
constexpr int BM = 256, BK = 64, HALF = 128, HTB = HALF * BK * 2  , STAGE_BYTES = 8 * HTB, NXCD = 8, WGM = 8;

__host__ __device__ __forceinline__ int lds_byte(int r, int c) { const int st = (r >> 4) * 2 + (c >> 5), rr = r & 15, cc = c & 31, ob = rr * 64 + cc * 2; return st * 1024 + (ob ^ (((ob >> 9) & 1) << 5)); }
__host__ __device__ __forceinline__ void stage_rc(int b, int& R, int& C) { const int st = b / 1024, sb = b % 1024, swz = sb ^ (((sb >> 9) & 1) << 5); R = (st >> 1) * 16 + swz / 64; C = (st & 1) * 32 + (swz % 64) / 2; }
__host__ __device__ __forceinline__ int perm32(int rho) { const int n = rho >> 4, i = rho & 15; return 8 * (i >> 2) + 4 * n + (i & 3); }

struct Unit { int pm, pn; };
struct Gemm { const bf16_t* A; const bf16_t* Bt; int M, N, K; };

struct StaticOrder {
    int nM, nN, nwg, G, c;
    __host__ __device__ void init(int M, int N, int G_, int c_) { nM = M / BM; nN = N / BM; nwg = nM * nN; G = G_; c = c_; }
    __host__ __device__ bool next(int i, Unit& u) const {
        const long L = (long)i * G + c; if (L >= nwg) return false;
        int wgid = (int)L; { const int q = nwg / NXCD, r = nwg % NXCD, xcd = wgid % NXCD, off = wgid / NXCD; wgid = (xcd < r ? xcd * (q + 1) : r * (q + 1) + (xcd - r) * q) + off; }
        const int nig = WGM * nN, gid = wgid / nig, fm = gid * WGM, gsz = (nM - fm) < WGM ? (nM - fm) : WGM;
        u.pm = fm + ((wgid % nig) % gsz); u.pn = (wgid % nig) / gsz; return true;
    }
    __device__ __forceinline__ void a_ready(const Unit&) const {}
    __device__ __forceinline__ void done(const Unit&) const {}
};

__device__ __forceinline__ unsigned cvt_pk_bf16(float lo, float hi) { unsigned r; asm volatile("v_cvt_pk_bf16_f32 %0, %1, %2" : "=v"(r) : "v"(lo), "v"(hi)); return r; }
template <class Epi, class Sched, bool ALIGN_EPI = false, bool SP2 = false>
__device__ __forceinline__ void gemm_phase(PG8_LAS unsigned char* lds, const Gemm g, const Sched& S, const Epi& E) {
    const int tid = threadIdx.x, wid = __builtin_amdgcn_readfirstlane(tid >> 6), lane = tid & 63, wr = wid >> 2, wc = wid & 3, fr = lane & 15, fq = lane >> 4;
    const int K = g.K, nt = K / BK;
    unsigned voffA[2], voffB[2];
#pragma unroll
    for (int i = 0; i < 2; ++i) { int R, C; stage_rc(tid * 16 + i * 8192, R, C); const int Rb = Epi::PERM ? ((R & ~31) + perm32(R & 31)) : R;
        voffA[i] = (unsigned)(R * K + C) * 2u; voffB[i] = (unsigned)(Rb * K + C) * 2u; }
    const size_t kstep = (size_t)(BK * 2);
    const size_t hstep = (size_t)HALF * K * 2;
    const size_t tstep = 2 * hstep;
    const unsigned ldsw = (unsigned)wid * 1024u;
    const int aoff = lds_byte(wr * 64 + fr, fq * 8), boff = lds_byte(wc * 32 + fr, fq * 8);
#define PG8_SA(b, h) (((b) * 2 + (h)) * HTB)
#define PG8_SB(b, h) ((4 + (b) * 2 + (h)) * HTB)
#define PG8_STAGE(bufoff, gbase, voff) do { _Pragma("unroll") for (int _i = 0; _i < 2; ++_i) \
        __builtin_amdgcn_global_load_lds((const unsigned*)((const char*)(gbase) + (voff)[_i]), (PG8_LAS unsigned*)(lds + (bufoff) + ldsw + _i * 8192), 16, 0, 0); } while (0)
#define PG8_LDA(dst, b, h) do { _Pragma("unroll") for (int m = 0; m < 4; ++m) _Pragma("unroll") for (int k = 0; k < 2; ++k) dst[m][k] = *(const PG8_LAS bf16x8*)(lds + PG8_SA(b, h) + aoff + m * 2048 + k * 1024); } while (0)
#define PG8_LDB(dst, b, h) do { _Pragma("unroll") for (int n = 0; n < 2; ++n) _Pragma("unroll") for (int k = 0; k < 2; ++k) dst[n][k] = *(const PG8_LAS bf16x8*)(lds + PG8_SB(b, h) + boff + n * 2048 + k * 1024); } while (0)
#define PG8_MMA(ai, bj, At, Bt) do { __builtin_amdgcn_s_setprio(1); _Pragma("unroll") for (int m = 0; m < 4; ++m) _Pragma("unroll") for (int n = 0; n < 2; ++n) _Pragma("unroll") for (int k = 0; k < 2; ++k) \
        acc[ai][bj][m][n] = __builtin_amdgcn_mfma_f32_16x16x32_bf16(Bt[n][k], At[m][k], acc[ai][bj][m][n], 0, 0, 0); __builtin_amdgcn_s_setprio(0); } while (0)
#define PG8_WAIT_V(n) asm volatile("s_waitcnt vmcnt(" #n ")" ::: "memory")
#define PG8_WAIT_L(n) asm volatile("s_waitcnt lgkmcnt(" #n ")" ::: "memory")
#define PG8_BAR __builtin_amdgcn_s_barrier()
#define PG8_SCHED __builtin_amdgcn_sched_barrier(0)
    Unit cur, nxt; int ui = 0;
    if (!S.next(0, cur)) return;
    f32x4 acc[2][2][4][2];
#pragma unroll
    for (int a = 0; a < 2; ++a)
#pragma unroll
        for (int b = 0; b < 2; ++b)
#pragma unroll
            for (int m = 0; m < 4; ++m)
#pragma unroll
                for (int n = 0; n < 2; ++n) acc[a][b][m][n] = (f32x4){0.f, 0.f, 0.f, 0.f};
    bf16x8 At[4][2], B0[2][2], B1[2][2];
    const char* cA = (const char*)g.A + (size_t)cur.pm * tstep; const char* cB = (const char*)g.Bt + (size_t)cur.pn * tstep;
    S.a_ready(cur);
    if constexpr (SP2) {
        PG8_STAGE(PG8_SB(0, 0), cB, voffB); PG8_STAGE(PG8_SB(0, 1), cB + hstep, voffB); PG8_STAGE(PG8_SA(0, 0), cA, voffA); PG8_STAGE(PG8_SA(0, 1), cA + hstep, voffA);
        if (wr == 1) PG8_BAR;
        PG8_WAIT_V(2); PG8_BAR;
        PG8_STAGE(PG8_SB(1, 0), cB + kstep, voffB); PG8_STAGE(PG8_SA(1, 0), cA + kstep, voffA); PG8_STAGE(PG8_SB(1, 1), cB + hstep + kstep, voffB);
        PG8_WAIT_V(6); PG8_BAR;
    } else {
        PG8_STAGE(PG8_SB(0, 0), cB, voffB); PG8_STAGE(PG8_SA(0, 0), cA, voffA); PG8_STAGE(PG8_SB(0, 1), cB + hstep, voffB); PG8_STAGE(PG8_SA(0, 1), cA + hstep, voffA);
        if (wr == 1) PG8_BAR;
        PG8_WAIT_V(4); PG8_BAR;
        PG8_STAGE(PG8_SB(1, 0), cB + kstep, voffB); PG8_STAGE(PG8_SA(1, 0), cA + kstep, voffA); PG8_STAGE(PG8_SB(1, 1), cB + hstep + kstep, voffB);
        PG8_WAIT_V(6); PG8_BAR;
    }
    for (;;) {
        const bool has_next = S.next(ui + 1, nxt);
        const char* nA = has_next ? (const char*)g.A + (size_t)nxt.pm * tstep : cA; const char* nB = has_next ? (const char*)g.Bt + (size_t)nxt.pn * tstep : cB;
        for (int t = 0; t < nt; t += 2) {
            const bool last = (t == nt - 2);
            const char* a1 = cA + (size_t)(t + 1) * kstep;
            const char* a2 = last ? nA : cA + (size_t)(t + 2) * kstep; const char* b2 = last ? nB : cB + (size_t)(t + 2) * kstep;
            const char* a3 = a2 + kstep; const char* b3 = b2 + kstep;
            if (last && has_next) S.a_ready(nxt);
            if constexpr (SP2) {
            PG8_LDB(B0, 0, 0); PG8_LDB(B1, 0, 1); PG8_SCHED; PG8_LDA(At, 0, 0); PG8_STAGE(PG8_SA(1, 1), a1 + hstep, voffA);
            PG8_WAIT_V(8); PG8_WAIT_L(0); PG8_BAR; PG8_MMA(0, 0, At, B0); PG8_MMA(0, 1, At, B1); PG8_BAR; PG8_SCHED;
            PG8_LDA(At, 0, 1); PG8_STAGE(PG8_SB(0, 0), b2, voffB); PG8_STAGE(PG8_SB(0, 1), b2 + hstep, voffB); PG8_STAGE(PG8_SA(0, 0), a2, voffA);
            PG8_WAIT_V(8); PG8_WAIT_L(0); PG8_BAR; PG8_MMA(1, 0, At, B0); PG8_MMA(1, 1, At, B1); PG8_BAR; PG8_SCHED;
            PG8_LDB(B0, 1, 0); PG8_LDB(B1, 1, 1); PG8_SCHED; PG8_LDA(At, 1, 0); PG8_STAGE(PG8_SA(0, 1), a2 + hstep, voffA);
            PG8_WAIT_V(8); PG8_WAIT_L(0); PG8_BAR; PG8_MMA(0, 0, At, B0); PG8_MMA(0, 1, At, B1); PG8_BAR; PG8_SCHED;
            PG8_LDA(At, 1, 1); PG8_STAGE(PG8_SB(1, 0), b3, voffB); PG8_STAGE(PG8_SB(1, 1), b3 + hstep, voffB); PG8_STAGE(PG8_SA(1, 0), a3, voffA);
            PG8_WAIT_V(8); PG8_WAIT_L(0); PG8_BAR; PG8_MMA(1, 0, At, B0); PG8_MMA(1, 1, At, B1); PG8_BAR; PG8_SCHED;
            } else {
            PG8_LDB(B0, 0, 0); PG8_SCHED; PG8_LDA(At, 0, 0); PG8_STAGE(PG8_SA(1, 1), a1 + hstep, voffA);
            PG8_WAIT_L(8); PG8_BAR; PG8_WAIT_L(0); PG8_MMA(0, 0, At, B0); PG8_BAR; PG8_SCHED;
            PG8_LDB(B1, 0, 1); PG8_STAGE(PG8_SB(0, 0), b2, voffB);
            PG8_BAR; PG8_WAIT_L(0); PG8_MMA(0, 1, At, B1); PG8_BAR;
            PG8_LDA(At, 0, 1); PG8_STAGE(PG8_SA(0, 0), a2, voffA);
            PG8_BAR; PG8_WAIT_L(0); PG8_MMA(1, 0, At, B0); PG8_BAR; PG8_SCHED;
            PG8_STAGE(PG8_SB(0, 1), b2 + hstep, voffB);
            PG8_WAIT_V(6); PG8_BAR; PG8_MMA(1, 1, At, B1); PG8_BAR;
            PG8_LDB(B0, 1, 0); PG8_SCHED; PG8_LDA(At, 1, 0); PG8_STAGE(PG8_SA(0, 1), a2 + hstep, voffA);
            PG8_WAIT_L(8); PG8_BAR; PG8_WAIT_L(0); PG8_MMA(0, 0, At, B0); PG8_BAR; PG8_SCHED;
            PG8_LDB(B1, 1, 1); PG8_STAGE(PG8_SB(1, 0), b3, voffB);
            PG8_BAR; PG8_WAIT_L(0); PG8_MMA(0, 1, At, B1); PG8_BAR;
            PG8_LDA(At, 1, 1); PG8_STAGE(PG8_SA(1, 0), a3, voffA);
            PG8_BAR; PG8_WAIT_L(0); PG8_MMA(1, 0, At, B0); PG8_BAR; PG8_SCHED;
            PG8_STAGE(PG8_SB(1, 1), b3 + hstep, voffB);
            PG8_WAIT_V(6); PG8_BAR; PG8_MMA(1, 1, At, B1); PG8_BAR;
            }
        }
        if constexpr (ALIGN_EPI) { if (wr == 0) PG8_BAR; }
        if constexpr (!Epi::AFTER_DRAIN) { E(acc, cur, wr, wc, fr, fq); S.done(cur); }
        if (!has_next) break;
#pragma unroll
        for (int a = 0; a < 2; ++a)
#pragma unroll
            for (int b = 0; b < 2; ++b)
#pragma unroll
                for (int m = 0; m < 4; ++m)
#pragma unroll
                    for (int n = 0; n < 2; ++n) acc[a][b][m][n] = (f32x4){0.f, 0.f, 0.f, 0.f};
        cur = nxt; cA = nA; cB = nB; ++ui;
        if constexpr (ALIGN_EPI) { if (wr == 1) PG8_BAR; }
    }
    PG8_WAIT_V(0);
    if constexpr (!ALIGN_EPI) { if (wr == 0) PG8_BAR; }
    PG8_BAR;
    if constexpr (Epi::AFTER_DRAIN) { E.fused(acc, cur, wr, wc, fr, fq, lds, wid, lane); S.done(cur); }
#undef PG8_SA
#undef PG8_SB
#undef PG8_STAGE
#undef PG8_LDA
#undef PG8_LDB
#undef PG8_MMA
#undef PG8_WAIT_V
#undef PG8_WAIT_L
#undef PG8_BAR
#undef PG8_SCHED
}
}

#define GAS __attribute__((address_space(1)))
#define LAS __attribute__((address_space(3)))
#define XB_TMO      128
#define XB_XCNT(j)  (256  + 64 * (j))
#define XB_XSUB(j)  (1280 + 64 * (j))
#define XB_XGEN(j)  (2304 + 64 * (j))
#define XB_TOP      3328
#define XB_TOPGEN   3392
#define XCD_BAR_WORDS 3456
#define XB_SPIN_CAP (1u << 18)

__device__ __forceinline__ unsigned xb_ld(unsigned* p)              { return __hip_atomic_load(p, __ATOMIC_RELAXED, __HIP_MEMORY_SCOPE_AGENT); }
__device__ __forceinline__ unsigned xb_add(unsigned* p, unsigned v) { return __hip_atomic_fetch_add(p, v, __ATOMIC_RELAXED, __HIP_MEMORY_SCOPE_AGENT); }
__device__ __forceinline__ unsigned xb_xcc_id() { return (unsigned)__builtin_amdgcn_s_getreg((3 << 11) | 20) & 0xFu; }
#define XB_SPIN(cond, bar) do { unsigned _sp = 0; while (cond) { __builtin_amdgcn_s_sleep(1); \
    if ((++_sp & 255u) == 0u) { if (xb_ld(&(bar)[XB_TMO])) break; if (_sp > XB_SPIN_CAP) { atomicAdd(&(bar)[XB_TMO], 1u); break; } } } } while (0)

struct XcdBarrier {
    unsigned* bar; unsigned x;
    volatile LAS unsigned* st;
};

__device__ __forceinline__ XcdBarrier xcd_barrier_post(unsigned* bar, volatile LAS unsigned* st) {
    XcdBarrier b; b.bar = bar; b.x = xb_xcc_id(); b.st = st;
    if (threadIdx.x == 0) (void)xb_add(&bar[XB_XCNT(b.x)], 1u);
    return b;
}
__device__ __forceinline__ void xcd_barrier_complete(unsigned* bar, unsigned x, unsigned& nloc, unsigned& nx) {
    const unsigned G = gridDim.x * gridDim.y * gridDim.z;
    unsigned sum, cnt, mine, sp = 0u;
    for (;;) {
        sum = 0u; cnt = 0u; mine = 0u;
#pragma unroll
        for (unsigned j = 0; j < 16; ++j) { const unsigned c = xb_ld(&bar[XB_XCNT(j)]); sum += c; cnt += (c > 0u) ? 1u : 0u; mine = (j == x) ? c : mine; }
        if (sum == G) break;
        __builtin_amdgcn_s_sleep(1);
        if ((++sp & 255u) == 0u) { if (xb_ld(&bar[XB_TMO])) break; if (sp > XB_SPIN_CAP) { atomicAdd(&bar[XB_TMO], 1u); break; } }
    }
    nloc = mine > 0u ? mine : 1u; nx = cnt > 0u ? cnt : 1u;
}

__device__ __forceinline__ void xcd_barrier(const XcdBarrier& b) {
    asm volatile("s_waitcnt vmcnt(0)" ::: "memory");
    __syncthreads();
    if (threadIdx.x == 0) {
        unsigned* bar = b.bar;
        __builtin_amdgcn_s_waitcnt(0);
        unsigned nloc = b.st[0], nx = b.st[1];
        if (nloc == 0u) { xcd_barrier_complete(bar, b.x, nloc, nx); b.st[0] = nloc; b.st[1] = nx; }
        const unsigned old = xb_add(&bar[XB_XSUB(b.x)], 1u);
        const unsigned gen = old / nloc;
        if (old + 1u == (gen + 1u) * nloc) {
            __builtin_amdgcn_fence(__ATOMIC_RELEASE, "agent");
            asm volatile("s_waitcnt vmcnt(0)" ::: "memory");
            const unsigned og = xb_add(&bar[XB_TOP], 1u);
            const unsigned tg = og / nx;
            if (og + 1u == (tg + 1u) * nx) xb_add(&bar[XB_TOPGEN], 1u);
            else XB_SPIN(xb_ld(&bar[XB_TOPGEN]) == tg, bar);
            __builtin_amdgcn_fence(__ATOMIC_ACQUIRE, "agent");
            xb_add(&bar[XB_XGEN(b.x)], 1u);
            asm volatile("s_waitcnt vmcnt(0)" ::: "memory");
        } else {
            XB_SPIN(xb_ld(&bar[XB_XGEN(b.x)]) == gen, bar);
            __builtin_amdgcn_fence(__ATOMIC_ACQUIRE, "agent");
            asm volatile("s_waitcnt vmcnt(0)" ::: "memory");
        }
    }
    __syncthreads();
}

constexpr int D = 1024, BATCH = 4, SEQ = 8192, NMETA = 16, LSEQ = SEQ + NMETA;
constexpr int T = BATCH * SEQ;
constexpr int NP = 2048, NQ = 2048, NEXP = 16384;
constexpr float EPS = 1e-6f;
constexpr int NWAVES = 8;

constexpr size_t MiB = 1u << 20;
constexpr size_t WS_CTL = 0, CTL_ZERO_BYTES = 1 * MiB;
constexpr int CW_BAR = 4096;
constexpr size_t WS_ROWSS = 512 * 1024;
constexpr size_t WS_WIN = 2 * MiB, WS_WOUT = 6 * MiB, WS_WQ = 8 * MiB, WS_KEYS = 12 * MiB, WS_RSTD1 = 13 * MiB;
constexpr size_t WS_UB = 16 * MiB, WS_VB = 48 * MiB, WS_XB = 80 * MiB  , WS_P = 144 * MiB  ;
constexpr size_t WS_H2B = 274 * MiB, WS_SELI = 338 * MiB, WS_SELG = 354 * MiB, WS_END = 370 * MiB;

constexpr int RING_BYTES = 131072, MISC_OFF = RING_BYTES + 320, LDS_BYTES = 147456;

typedef unsigned short bf16;
typedef unsigned v4u __attribute__((ext_vector_type(4)));
typedef unsigned v2u __attribute__((ext_vector_type(2)));
typedef float f32x4 __attribute__((ext_vector_type(4)));
typedef float f32x16 __attribute__((ext_vector_type(16)));
typedef short bf16x8 __attribute__((ext_vector_type(8)));
typedef __bf16 bf16x2_t __attribute__((ext_vector_type(2)));
#define LDS_WAIT() asm volatile("s_waitcnt lgkmcnt(0)" ::: "memory")

__device__ __forceinline__ unsigned f2bf(float f) { unsigned u = __builtin_bit_cast(unsigned, f); return (u + 0x7fffu + ((u >> 16) & 1u)) >> 16; }
__device__ __forceinline__ unsigned pk2(float lo, float hi) { return f2bf(lo) | (f2bf(hi) << 16); }
__device__ __forceinline__ float bflo(unsigned w) { return __builtin_bit_cast(float, w << 16); }
__device__ __forceinline__ float bfhi(unsigned w) { return __builtin_bit_cast(float, w & 0xffff0000u); }
__device__ __forceinline__ float wave_sum(float v) {
#pragma unroll
    for (int o = 1; o < 64; o <<= 1) v += __shfl_xor(v, o);
    return v;
}

struct EpiP {
    static constexpr bool PERM = true, AFTER_DRAIN = false;
    bf16* P; const float* rstd;
    __device__ __forceinline__ void operator()(const pg8::f32x4 (&acc)[2][2][4][2], const pg8::Unit& u, int wr, int wc, int fr, int fq) const {
        const int row0 = u.pm * 256 + wr * 64 + fr, col0 = u.pn * 256 + wc * 32 + 8 * fq;
#pragma unroll
        for (int ai = 0; ai < 2; ++ai)
#pragma unroll
            for (int m = 0; m < 4; ++m) {
                const int row = row0 + ai * 128 + m * 16; const float rs = rstd[row];
                bf16* rowp = P + ((size_t)(row >> 13) * LSEQ + NMETA + (row & 8191)) * NP + col0;
#pragma unroll
                for (int bj = 0; bj < 2; ++bj) { const pg8::f32x4 v0 = acc[ai][bj][m][0] * rs, v1 = acc[ai][bj][m][1] * rs;
                    v4u w; w.x = pg8::cvt_pk_bf16(v0[0], v0[1]); w.y = pg8::cvt_pk_bf16(v0[2], v0[3]); w.z = pg8::cvt_pk_bf16(v1[0], v1[1]); w.w = pg8::cvt_pk_bf16(v1[2], v1[3]);
                    *(v4u*)(rowp + bj * 128) = w; }
            }
    }
};
struct EpiH2 {
    static constexpr bool PERM = true, AFTER_DRAIN = false;
    const float* X; float* H2; bf16* H2B; float* rowss;
    __device__ __forceinline__ void operator()(const pg8::f32x4 (&acc)[2][2][4][2], const pg8::Unit& u, int wr, int wc, int fr, int fq) const {
        const int row0 = u.pm * 256 + wr * 64 + fr, col0 = u.pn * 256 + wc * 32 + 8 * fq;
#pragma unroll
        for (int ai = 0; ai < 2; ++ai)
#pragma unroll
            for (int m = 0; m < 4; ++m) {
                const int row = row0 + ai * 128 + m * 16; const size_t off = (size_t)row * D + col0; float ss = 0.f;
#pragma unroll
                for (int bj = 0; bj < 2; ++bj) {
                    const pg8::f32x4 x0 = *(const pg8::f32x4*)(X + off + bj * 128), x1 = *(const pg8::f32x4*)(X + off + bj * 128 + 4);
                    const pg8::f32x4 v0 = acc[ai][bj][m][0] + x0, v1 = acc[ai][bj][m][1] + x1;
                    *(pg8::f32x4*)(H2 + off + bj * 128) = v0; *(pg8::f32x4*)(H2 + off + bj * 128 + 4) = v1;
                    v4u w; w.x = pg8::cvt_pk_bf16(v0[0], v0[1]); w.y = pg8::cvt_pk_bf16(v0[2], v0[3]); w.z = pg8::cvt_pk_bf16(v1[0], v1[1]); w.w = pg8::cvt_pk_bf16(v1[2], v1[3]);
                    *(v4u*)(H2B + off + bj * 128) = w;
                    ss += (v0[0] * v0[0] + v0[1] * v0[1]) + (v0[2] * v0[2] + v0[3] * v0[3]) + (v1[0] * v1[0] + v1[1] * v1[1]) + (v1[2] * v1[2] + v1[3] * v1[3]);
                }
                ss += __shfl_xor(ss, 16); ss += __shfl_xor(ss, 32);
                if (fq == 0) atomicAdd(rowss + row, ss);
            }
    }
};
struct EpiQ {
    static constexpr bool PERM = true, AFTER_DRAIN = false;
    bf16* Q; const float* rowss;
    __device__ __forceinline__ void operator()(const pg8::f32x4 (&acc)[2][2][4][2], const pg8::Unit& u, int wr, int wc, int fr, int fq) const {
        const int row0 = u.pm * 256 + wr * 64 + fr, col0 = u.pn * 256 + wc * 32 + 8 * fq;
#pragma unroll
        for (int ai = 0; ai < 2; ++ai)
#pragma unroll
            for (int m = 0; m < 4; ++m) {
                const int row = row0 + ai * 128 + m * 16; const float rs = rsqrtf(rowss[row] * (1.0f / D) + EPS);
                bf16* rowp = Q + (size_t)row * NQ + col0;
#pragma unroll
                for (int bj = 0; bj < 2; ++bj) { const pg8::f32x4 v0 = acc[ai][bj][m][0] * rs, v1 = acc[ai][bj][m][1] * rs;
                    v4u w; w.x = pg8::cvt_pk_bf16(v0[0], v0[1]); w.y = pg8::cvt_pk_bf16(v0[2], v0[3]); w.z = pg8::cvt_pk_bf16(v1[0], v1[1]); w.w = pg8::cvt_pk_bf16(v1[2], v1[3]);
                    *(v4u*)(rowp + bj * 128) = w; }
            }
    }
};

__device__ __forceinline__ void row_to_bf16(const float* src, bf16* dst, const float* gain, float* rstd_out, int lane) {
    const f32x4* xr = (const f32x4*)src + lane;
    f32x4 v[4]; float s = 0.f;
#pragma unroll
    for (int j = 0; j < 4; ++j) { v[j] = xr[64 * j]; s += (v[j].x * v[j].x + v[j].y * v[j].y) + (v[j].z * v[j].z + v[j].w * v[j].w); }
    if (rstd_out) { s = wave_sum(s); if (lane == 0) *rstd_out = rsqrtf(s * (1.0f / D) + EPS); }
    if (gain) {
#pragma unroll
        for (int j = 0; j < 4; ++j) v[j] = v[j] * ((const f32x4*)gain)[lane + 64 * j];
    }
    unsigned long long* o8 = (unsigned long long*)dst + lane;
#pragma unroll
    for (int j = 0; j < 4; ++j) o8[64 * j] = (unsigned long long)pk2(v[j].x, v[j].y) | ((unsigned long long)pk2(v[j].z, v[j].w) << 32);
}
__device__ __forceinline__ void p0_transpose_item(const float* W, int K, int N, const float* gain, bf16* WT, LAS float* scr, int item, int lane) {
    const int nblk = N / 32, kb = item / nblk, nb = item % nblk, k0 = 64 * kb, n0 = 32 * nb;
#pragma unroll 8
    for (int i = 0; i < 32; ++i) { const int kk = 2 * i + (lane >> 5); const float gk = gain ? gain[k0 + kk] : 1.0f; scr[kk * 33 + (lane & 31)] = W[(size_t)(k0 + kk) * N + n0 + (lane & 31)] * gk; }
    LDS_WAIT(); asm volatile("" ::: "memory");
    const int c = lane & 7;
#pragma unroll
    for (int j = 0; j < 4; ++j) { const int n = (lane >> 3) + 8 * j; const LAS float* s = scr + (8 * c) * 33 + n;
        v4u o; o.x = pk2(s[0 * 33], s[1 * 33]); o.y = pk2(s[2 * 33], s[3 * 33]); o.z = pk2(s[4 * 33], s[5 * 33]); o.w = pk2(s[6 * 33], s[7 * 33]);
        *(v4u*)(WT + (size_t)(n0 + n) * K + k0 + 8 * c) = o; }
    LDS_WAIT(); asm volatile("" ::: "memory");
}
__device__ __forceinline__ void p0_weff_item(const float* w_out, const float* pool_w, const float* pool_scale, bf16* WoutT, int item, int lane) {
    const int nb = item & 15, cg = (item >> 4) & 15, g = item >> 8;
    const int n = nb * 64 + lane;
    float acc[8];
#pragma unroll
    for (int i = 0; i < 8; ++i) acc[i] = 0.f;
    const float* wo = w_out + (size_t)(512 + g * 128) * D + n;
    const float* pw = pool_w + (size_t)(g * 128 + cg * 8) * 128;
    const float* ps = pool_scale + g * 128;
#pragma unroll 4
    for (int d = 0; d < 128; ++d) { const float w = wo[(size_t)d * D] * ps[d];
#pragma unroll
        for (int i = 0; i < 8; ++i) acc[i] += pw[i * 128 + d] * w; }
    v4u o; o.x = pk2(acc[0], acc[1]); o.y = pk2(acc[2], acc[3]); o.z = pk2(acc[4], acc[5]); o.w = pk2(acc[6], acc[7]);
    *(v4u*)(WoutT + (size_t)n * D + 512 + g * 128 + cg * 8) = o;
}
__device__ __forceinline__ void p0_meta(const float* meta, const float* g1, const float* w_in, bf16* P, LAS unsigned char* lds, int blk, int tid) {
    LAS float* mg = (LAS float*)lds;
    LAS float* part = (LAS float*)(lds + 65536);
    LAS float* rs = (LAS float*)(lds + 65536 + 32768);
    const int wave = tid >> 6, lane = tid & 63;
    for (int i = tid; i < 16 * 1024; i += 512) mg[i] = meta[i] * g1[i & 1023];
#pragma unroll
    for (int jj = 0; jj < 2; ++jj) { const int j = wave * 2 + jj; float s = 0.f;
        for (int k = lane; k < 1024; k += 64) { const float v = meta[j * 1024 + k]; s += v * v; }
        s = wave_sum(s); if (lane == 0) rs[j] = rsqrtf(s * (1.0f / D) + EPS); }
    __syncthreads();
    const int nn = tid & 7, kq = tid >> 3;
    float acc[16];
#pragma unroll
    for (int j = 0; j < 16; ++j) acc[j] = 0.f;
#pragma unroll 4
    for (int kk = 0; kk < 16; ++kk) { const int k = 16 * kq + kk; const float w = w_in[(size_t)k * NP + 8 * blk + nn];
#pragma unroll
        for (int j = 0; j < 16; ++j) acc[j] += mg[j * 1024 + k] * w; }
#pragma unroll
    for (int j = 0; j < 16; ++j) part[(kq * 16 + j) * 8 + nn] = acc[j];
    __syncthreads();
    if (tid < 128) { const int j = tid >> 3; float s = 0.f;
        for (int q = 0; q < 64; ++q) s += part[(q * 16 + j) * 8 + nn];
        const bf16 o = (bf16)f2bf(s * rs[j]);
#pragma unroll
        for (int b = 0; b < BATCH; ++b) P[((size_t)b * LSEQ + j) * NP + 8 * blk + nn] = o; }
    __syncthreads();
}

__device__ __forceinline__ void ld8(const bf16* p, float (&f)[8]) {
    const v4u w = *(const v4u*)p;
    f[0] = bflo(w.x); f[1] = bfhi(w.x); f[2] = bflo(w.y); f[3] = bfhi(w.y); f[4] = bflo(w.z); f[5] = bfhi(w.z); f[6] = bflo(w.w); f[7] = bfhi(w.w);
}
__device__ __forceinline__ void st8(bf16* p, const float (&f)[8]) {
    v4u o; o.x = pk2(f[0], f[1]); o.y = pk2(f[2], f[3]); o.z = pk2(f[4], f[5]); o.w = pk2(f[6], f[7]); *(v4u*)p = o;
}
__device__ __forceinline__ void p2_convpool(const bf16* P, const float* conv_w, const float* conv_b, bf16* Y, int blk, int tid) {
    const int cgp = tid & 127, run = tid >> 7;
    const int r_start = blk * 128 + run * 32;
    const int b = r_start >> 13, l0 = NMETA + (r_start & 8191);
    const bf16* Pb = P + (size_t)b * LSEQ * NP;
    if (cgp < 64) {
        const int c0 = cgp * 8;
        float w0[8], w1[8], w2[8], cb[8];
#pragma unroll
        for (int i = 0; i < 8; ++i) { w0[i] = conv_w[c0 + i]; w1[i] = conv_w[512 + c0 + i]; w2[i] = conv_w[1024 + c0 + i]; cb[i] = conv_b[c0 + i]; }
        float zp[8], zc[8], zn[8], a[8], c[8], bg[8], y[8];
        ld8(Pb + (size_t)(l0 - 1) * NP + c0, a); ld8(Pb + (size_t)(l0 - 1) * NP + 1024 + c0, c);
#pragma unroll
        for (int i = 0; i < 8; ++i) zp[i] = a[i] * c[i];
        ld8(Pb + (size_t)l0 * NP + c0, a); ld8(Pb + (size_t)l0 * NP + 1024 + c0, c);
#pragma unroll
        for (int i = 0; i < 8; ++i) zc[i] = a[i] * c[i];
        for (int t = 0; t < 32; ++t) { const int l = l0 + t;
            if (l + 1 < LSEQ) { ld8(Pb + (size_t)(l + 1) * NP + c0, a); ld8(Pb + (size_t)(l + 1) * NP + 1024 + c0, c);
#pragma unroll
                for (int i = 0; i < 8; ++i) zn[i] = a[i] * c[i]; }
            else {
#pragma unroll
                for (int i = 0; i < 8; ++i) zn[i] = 0.f; }
            ld8(Pb + (size_t)l * NP + 512 + c0, bg);
#pragma unroll
            for (int i = 0; i < 8; ++i) { y[i] = bg[i] * (w0[i] * zp[i] + w1[i] * zc[i] + w2[i] * zn[i] + cb[i]); zp[i] = zc[i]; zc[i] = zn[i]; }
            st8(Y + (size_t)(r_start + t) * D + c0, y); }
    } else {
        const int c0 = (cgp - 64) * 8, g = c0 >> 7, hw = 1 << g;
        const bf16* Hb = Pb + 1536 + c0;
        float S[8], v[8], m[8];
#pragma unroll
        for (int i = 0; i < 8; ++i) S[i] = 0.f;
        { const int hi0 = (l0 + hw < LSEQ) ? l0 + hw : LSEQ;
          for (int j = l0 - hw; j < hi0; ++j) { ld8(Hb + (size_t)j * NP, v);
#pragma unroll
              for (int i = 0; i < 8; ++i) S[i] += v[i]; } }
        for (int t = 0; t < 32; ++t) { const int l = l0 + t; const int hi = (l + hw < LSEQ) ? l + hw : LSEQ; const float inv = 1.0f / (float)(hi - (l - hw));
            ld8(Hb + (size_t)l * NP, v);
#pragma unroll
            for (int i = 0; i < 8; ++i) m[i] = S[i] * inv - v[i];
            st8(Y + (size_t)(r_start + t) * D + 512 + c0, m);
            ld8(Hb + (size_t)(l - hw) * NP, v);
#pragma unroll
            for (int i = 0; i < 8; ++i) S[i] -= v[i];
            if (l + hw < LSEQ) { ld8(Hb + (size_t)(l + hw) * NP, v);
#pragma unroll
                for (int i = 0; i < 8; ++i) S[i] += v[i]; } }
    }
}

#define MFMA32(a, b, c) __builtin_amdgcn_mfma_f32_32x32x16_bf16((a), (b), (c), 0, 0, 0)
__device__ __forceinline__ float mkcand(float a, float b, unsigned tag) { return __builtin_bit_cast(float, (__builtin_bit_cast(unsigned, a + b) & ~0xFFu) | tag); }
__device__ __forceinline__ unsigned keylook(unsigned long long lo, unsigned long long hi, unsigned i) {
    const unsigned long long w = (i < 8u) ? lo : hi;
    return (unsigned)(w >> (8u * (i & 7u))) & 127u;
}
__device__ __forceinline__ void p5_item(const bf16* Q, const bf16* KB, int* SI, float* SG, int tg, int head, int lane) {
    const int r = lane & 31, h = lane >> 5;
    const int tok = tg * 32 + r;
    const float NEG = -__builtin_inff();
    float sv[2][16];
#pragma unroll
    for (int p = 0; p < 2; ++p) {
        const int hp = head * 2 + p;
        f32x16 acc[4];
#pragma unroll
        for (int kt = 0; kt < 4; ++kt)
#pragma unroll
            for (int i = 0; i < 16; ++i) acc[kt][i] = 0.f;
        const bf16* qrow = Q + (size_t)tok * NQ + hp * 128 + 8 * h;
        const bf16* kb = KB + ((size_t)hp * 128 + r) * 128 + 8 * h;
#pragma unroll
        for (int s = 0; s < 8; ++s) {
            const bf16x8 bq = *(const bf16x8*)(qrow + 16 * s);
#pragma unroll
            for (int kt = 0; kt < 4; ++kt) { const bf16x8 ak = *(const bf16x8*)(kb + (size_t)kt * 32 * 128 + 16 * s); acc[kt] = MFMA32(ak, bq, acc[kt]); }
        }
        float v[64];
#pragma unroll
        for (int kt = 0; kt < 4; ++kt)
#pragma unroll
            for (int i = 0; i < 16; ++i) { const unsigned key = 32u * kt + (i & 3) + 8u * (i >> 2) + 4u * h;
                v[kt * 16 + i] = __builtin_bit_cast(float, (__builtin_bit_cast(unsigned, acc[kt][i]) & ~127u) | key); }
#pragma unroll
        for (int t = 0; t < 16; ++t) {
            float m = v[0];
#pragma unroll
            for (int i = 1; i < 64; ++i) m = fmaxf(m, v[i]);
            m = fmaxf(m, __shfl_xor(m, 32));
            sv[p][t] = m;
            const unsigned mb = __builtin_bit_cast(unsigned, m);
#pragma unroll
            for (int i = 0; i < 64; ++i) v[i] = (__builtin_bit_cast(unsigned, v[i]) == mb) ? NEG : v[i];
        }
    }
    float cv[50];
#define P5_CROW(I, NJ, BASE) _Pragma("unroll") for (int j = 0; j < NJ; ++j) cv[BASE + j] = mkcand(sv[0][I], sv[1][j], (unsigned)((I << 4) | j));
    P5_CROW(0, 16, 0) P5_CROW(1, 8, 16) P5_CROW(2, 5, 24) P5_CROW(3, 4, 29) P5_CROW(4, 3, 33) P5_CROW(5, 2, 36) P5_CROW(6, 2, 38) P5_CROW(7, 2, 40)
    P5_CROW(8, 1, 42) P5_CROW(9, 1, 43) P5_CROW(10, 1, 44) P5_CROW(11, 1, 45) P5_CROW(12, 1, 46) P5_CROW(13, 1, 47) P5_CROW(14, 1, 48) P5_CROW(15, 1, 49)
#undef P5_CROW
    unsigned long long K0lo = 0ull, K0hi = 0ull, K1lo = 0ull, K1hi = 0ull;
#pragma unroll
    for (int i = 0; i < 8; ++i) {
        K0lo |= (unsigned long long)(__builtin_bit_cast(unsigned, sv[0][i]) & 127u) << (8 * i); K0hi |= (unsigned long long)(__builtin_bit_cast(unsigned, sv[0][8 + i]) & 127u) << (8 * i);
        K1lo |= (unsigned long long)(__builtin_bit_cast(unsigned, sv[1][i]) & 127u) << (8 * i); K1hi |= (unsigned long long)(__builtin_bit_cast(unsigned, sv[1][8 + i]) & 127u) << (8 * i); }
    float sel[16];
#pragma unroll
    for (int t = 0; t < 16; ++t) {
        float m = cv[0];
#pragma unroll
        for (int i = 1; i < 50; ++i) m = fmaxf(m, cv[i]);
        sel[t] = m;
        const unsigned mb = __builtin_bit_cast(unsigned, m);
#pragma unroll
        for (int i = 0; i < 50; ++i) cv[i] = (__builtin_bit_cast(unsigned, cv[i]) == mb) ? NEG : cv[i];
    }
    float e[16], esum = 0.f; int eidx[16];
#pragma unroll
    for (int t = 0; t < 16; ++t) { e[t] = __expf(sel[t] - sel[0]); esum += e[t];
        const unsigned tag = __builtin_bit_cast(unsigned, sel[t]) & 0xFFu;
        eidx[t] = (int)(keylook(K0lo, K0hi, tag >> 4) * 128u + keylook(K1lo, K1hi, tag & 15u)); }
    const float inv = 1.0f / esum;
    if (h == 0) { int* o = SI + (size_t)tok * 128 + head * 16;
#pragma unroll
        for (int t = 0; t < 16; t += 4) *(int4*)(o + t) = make_int4(eidx[t], eidx[t + 1], eidx[t + 2], eidx[t + 3]); }
    else { float* o = SG + (size_t)tok * 128 + head * 16;
#pragma unroll
        for (int t = 0; t < 16; t += 4) *(f32x4*)(o + t) = (f32x4){e[t] * inv, e[t + 1] * inv, e[t + 2] * inv, e[t + 3] * inv}; }
}


__device__ __forceinline__ float wave_max(float v) {
#pragma unroll
    for (int o = 1; o < 64; o <<= 1) v = fmaxf(v, __shfl_xor(v, o));
    return v;
}
__device__ __forceinline__ float pick4(float a, float b, float c, float d, int k) { return (k < 2) ? ((k == 0) ? a : b) : ((k == 2) ? c : d); }
__device__ __forceinline__ void p5_simple(const bf16* Q, const bf16* KB, int* SI, float* SG, int tok, int head, int lane) {
    const float NEG = -__builtin_inff();
    float s[2][2];
#pragma unroll
    for (int p = 0; p < 2; ++p) { const int hp = head * 2 + p; const bf16* qrow = Q + (size_t)tok * NQ + hp * 128;
#pragma unroll
        for (int kk = 0; kk < 2; ++kk) { const unsigned key = lane + 64 * kk; const bf16* kr = KB + ((size_t)hp * 128 + key) * 128; float acc = 0.f;
            for (int d = 0; d < 128; d += 8) { float qf[8], kf[8]; ld8(qrow + d, qf); ld8(kr + d, kf);
#pragma unroll
                for (int i = 0; i < 8; ++i) acc += qf[i] * kf[i]; }
            s[p][kk] = __builtin_bit_cast(float, (__builtin_bit_cast(unsigned, acc) & ~127u) | key); } }
    float sv[2][16];
#pragma unroll
    for (int p = 0; p < 2; ++p)
#pragma unroll
        for (int t = 0; t < 16; ++t) { const float m = wave_max(fmaxf(s[p][0], s[p][1])); sv[p][t] = m; const unsigned mb = __builtin_bit_cast(unsigned, m);
            s[p][0] = (__builtin_bit_cast(unsigned, s[p][0]) == mb) ? NEG : s[p][0]; s[p][1] = (__builtin_bit_cast(unsigned, s[p][1]) == mb) ? NEG : s[p][1]; }
    const int j = lane & 15, ib = lane >> 4;
    float s1j = sv[1][0];
#pragma unroll
    for (int jj = 1; jj < 16; ++jj) s1j = (j == jj) ? sv[1][jj] : s1j;
    float cv[4];
#pragma unroll
    for (int q = 0; q < 4; ++q) { const float s0i = pick4(sv[0][4 * q], sv[0][4 * q + 1], sv[0][4 * q + 2], sv[0][4 * q + 3], ib);
        cv[q] = mkcand(s0i, s1j, (unsigned)(((4 * q + ib) << 4) | j)); }
    unsigned long long K0lo = 0ull, K0hi = 0ull, K1lo = 0ull, K1hi = 0ull;
#pragma unroll
    for (int i = 0; i < 8; ++i) {
        K0lo |= (unsigned long long)(__builtin_bit_cast(unsigned, sv[0][i]) & 127u) << (8 * i); K0hi |= (unsigned long long)(__builtin_bit_cast(unsigned, sv[0][8 + i]) & 127u) << (8 * i);
        K1lo |= (unsigned long long)(__builtin_bit_cast(unsigned, sv[1][i]) & 127u) << (8 * i); K1hi |= (unsigned long long)(__builtin_bit_cast(unsigned, sv[1][8 + i]) & 127u) << (8 * i); }
    float sel[16];
#pragma unroll
    for (int t = 0; t < 16; ++t) { const float m = wave_max(fmaxf(fmaxf(cv[0], cv[1]), fmaxf(cv[2], cv[3]))); sel[t] = m; const unsigned mb = __builtin_bit_cast(unsigned, m);
#pragma unroll
        for (int q = 0; q < 4; ++q) cv[q] = (__builtin_bit_cast(unsigned, cv[q]) == mb) ? NEG : cv[q]; }
    float e[16], esum = 0.f; int eidx[16];
#pragma unroll
    for (int t = 0; t < 16; ++t) { e[t] = __expf(sel[t] - sel[0]); esum += e[t];
        const unsigned tag = __builtin_bit_cast(unsigned, sel[t]) & 0xFFu;
        eidx[t] = (int)(keylook(K0lo, K0hi, tag >> 4) * 128u + keylook(K1lo, K1hi, tag & 15u)); }
    const float inv = 1.0f / esum;
    if (lane == 0) { int* o = SI + (size_t)tok * 128 + head * 16; float* og = SG + (size_t)tok * 128 + head * 16;
#pragma unroll
        for (int t = 0; t < 16; ++t) { o[t] = eidx[t]; og[t] = e[t] * inv; } }
}

__device__ __forceinline__ void p6_token(const bf16* H2B, const float* rowss, const int* SI, const float* SG, const bf16* UB, const bf16* VB, const float* gf, float* OUT, int tok, int lane) {
    const v4u* hb = (const v4u*)(H2B + (size_t)tok * D);
    const v4u xa = hb[lane], xb = hb[64 + lane];
    const unsigned xw[8] = {xa.x, xa.y, xa.z, xa.w, xb.x, xb.y, xb.z, xb.w};
    const float rstd2 = rsqrtf(rowss[tok] * (1.0f / D) + EPS);
    const int id0 = SI[(size_t)tok * 128 + lane], id1 = SI[(size_t)tok * 128 + 64 + lane];
    const float g0 = SG[(size_t)tok * 128 + lane], g1 = SG[(size_t)tok * 128 + 64 + lane];
    float out[16];
#pragma unroll
    for (int i = 0; i < 16; ++i) out[i] = 0.f;
    for (int e0 = 0; e0 < 128; e0 += 8) {
        v4u ur[8][2], vr[8][2]; float gt[8];
#pragma unroll
        for (int k = 0; k < 8; ++k) { const int e = e0 + k;
            const int idx = __builtin_amdgcn_readlane((e0 < 64) ? id0 : id1, e & 63);
            gt[k] = __builtin_bit_cast(float, __builtin_amdgcn_readlane(__builtin_bit_cast(int, (e0 < 64) ? g0 : g1), e & 63));
            const v4u* up = (const v4u*)(UB + (size_t)idx * D); const v4u* vp = (const v4u*)(VB + (size_t)idx * D);
            ur[k][0] = up[lane]; ur[k][1] = up[64 + lane]; vr[k][0] = vp[lane]; vr[k][1] = vp[64 + lane]; }
#pragma unroll
        for (int k = 0; k < 8; ++k) {
            const unsigned uw[8] = {ur[k][0].x, ur[k][0].y, ur[k][0].z, ur[k][0].w, ur[k][1].x, ur[k][1].y, ur[k][1].z, ur[k][1].w};
            float d = 0.f;
#pragma unroll
            for (int j = 0; j < 8; ++j) d = __builtin_amdgcn_fdot2_f32_bf16(__builtin_bit_cast(bf16x2_t, uw[j]), __builtin_bit_cast(bf16x2_t, xw[j]), d, false);
            d = wave_sum(d);
            const float a = d * rstd2;
            const float w = gt[k] * 0.5f * a * (1.0f + erff(a * 0.70710678118654752f));
            const unsigned vw[8] = {vr[k][0].x, vr[k][0].y, vr[k][0].z, vr[k][0].w, vr[k][1].x, vr[k][1].y, vr[k][1].z, vr[k][1].w};
#pragma unroll
            for (int j = 0; j < 8; ++j) { out[2 * j] += w * bflo(vw[j]); out[2 * j + 1] += w * bfhi(vw[j]); }
        }
    }
    f32x4* op = (f32x4*)(OUT + (size_t)tok * D);
    const f32x4* gp = (const f32x4*)gf;
    f32x4 y[4]; const int fi[4] = {2 * lane, 2 * lane + 1, 128 + 2 * lane, 129 + 2 * lane};
    float ss = 0.f;
#pragma unroll
    for (int q = 0; q < 4; ++q) { const f32x4 hv = op[fi[q]]; y[q] = (f32x4){hv.x + out[4 * q], hv.y + out[4 * q + 1], hv.z + out[4 * q + 2], hv.w + out[4 * q + 3]};
        ss += (y[q].x * y[q].x + y[q].y * y[q].y) + (y[q].z * y[q].z + y[q].w * y[q].w); }
    ss = wave_sum(ss);
    const float rs = rsqrtf(ss * (1.0f / D) + EPS);
#pragma unroll
    for (int q = 0; q < 4; ++q) op[fi[q]] = y[q] * rs * gp[fi[q]];
}

struct Args { const float* in[15]; float* out; unsigned char* ws; int ph_lo, ph_hi; };
constexpr int NPHASE = 7;
#define P5_SIMPLE 1
#ifndef MK_N_LAUNCHES
#define MK_N_LAUNCHES 7
#endif

__global__ void __launch_bounds__(NWAVES * 64, 2) fwd_kernel(Args args) {
    extern __shared__ __attribute__((aligned(16))) unsigned char lds_raw[];
    LAS unsigned char* lds = (LAS unsigned char*)lds_raw;
    volatile LAS unsigned* MISC = (volatile LAS unsigned*)(lds + MISC_OFF);
    const int tid = threadIdx.x, lane = tid & 63, wave = __builtin_amdgcn_readfirstlane(tid >> 6);
    const int G = gridDim.x, blk = blockIdx.x;
    unsigned char* ws = args.ws;
    const float* x = args.in[0]; const float* meta = args.in[1]; const float* g1 = args.in[2]; const float* w_in = args.in[3];
    const float* conv_w = args.in[4]; const float* conv_b = args.in[5]; const float* pool_w = args.in[6]; const float* pool_scale = args.in[7];
    const float* w_out = args.in[8]; const float* g2 = args.in[9]; const float* w_q = args.in[10]; const float* keys = args.in[11];
    const float* pu = args.in[12]; const float* pv = args.in[13]; const float* gf = args.in[14];
    bf16* WinT = (bf16*)(ws + WS_WIN); bf16* WoutT = (bf16*)(ws + WS_WOUT); bf16* WqT = (bf16*)(ws + WS_WQ); bf16* KB = (bf16*)(ws + WS_KEYS);
    float* rstd1 = (float*)(ws + WS_RSTD1); float* rowss = (float*)(ws + WS_ROWSS);
    bf16* UB = (bf16*)(ws + WS_UB); bf16* VB = (bf16*)(ws + WS_VB); bf16* XB = (bf16*)(ws + WS_XB); bf16* YP = (bf16*)(ws + WS_XB);
    bf16* P = (bf16*)(ws + WS_P); bf16* Qb = (bf16*)(ws + WS_P); bf16* H2B = (bf16*)(ws + WS_H2B);
    int* SI = (int*)(ws + WS_SELI); float* SG = (float*)(ws + WS_SELG);

    for (int u = tid; u < (LDS_BYTES - RING_BYTES) / 4; u += NWAVES * 64) ((LAS unsigned*)(lds + RING_BYTES))[u] = 0u;
    __syncthreads();
    const int lo = args.ph_lo, hi = args.ph_hi;
    XcdBarrier bar; bar.bar = (unsigned*)(ws + WS_CTL) + CW_BAR; bar.x = 0; bar.st = nullptr;
    if (hi - lo > 1) bar = xcd_barrier_post((unsigned*)(ws + WS_CTL) + CW_BAR, MISC + 8);
#define IN(k) (lo <= (k) && (k) < hi)
#define SEAM(k) do { if (IN(k) && IN((k) + 1)) xcd_barrier(bar); } while (0)
    const int gw = blk * NWAVES + wave, NGW = G * NWAVES;

    if (IN(0)) {
        for (int mb = blk; mb < 256; mb += G) p0_meta(meta, g1, w_in, P, lds, mb, tid);
        LAS float* scr = (LAS float*)(lds + wave * 16384);
        for (int it = gw; it < 1024 + 1024 + 256 + 1024; it += NGW) {
            int r = __builtin_amdgcn_readfirstlane(it);
            if (r < 1024) { p0_transpose_item(w_in, D, NP, g1, WinT, scr, r, lane); continue; } r -= 1024;
            if (r < 1024) { p0_transpose_item(w_q, D, NQ, g2, WqT, scr, r, lane); continue; } r -= 1024;
            if (r < 256) { p0_transpose_item(w_out, D, D, nullptr, WoutT, scr, r, lane); continue; } r -= 256;
            p0_weff_item(w_out, pool_w, pool_scale, WoutT, r, lane);
        }
        for (int m = gw; m < T; m += NGW) row_to_bf16(x + (size_t)m * D, XB + (size_t)m * D, nullptr, rstd1 + m, lane);
        for (int m = gw; m < NEXP; m += NGW) { row_to_bf16(pu + (size_t)m * D, UB + (size_t)m * D, g2, nullptr, lane); row_to_bf16(pv + (size_t)m * D, VB + (size_t)m * D, nullptr, nullptr, lane); }
        for (int m = gw; m < 256; m += NGW) row_to_bf16(keys + (size_t)m * D, KB + (size_t)m * D, nullptr, nullptr, lane);
    }
    SEAM(0);
    if (IN(1)) {
        pg8::Gemm g{XB, WinT, T, NP, D}; pg8::StaticOrder S; S.init(T, NP, G, blk);
        EpiP E{P, rstd1};
        pg8::gemm_phase<EpiP, pg8::StaticOrder, true, true>(lds, g, S, E);
    }
    SEAM(1);
    if (IN(2)) {
        for (int b2 = blk; b2 < T / 128; b2 += G) p2_convpool(P, conv_w, conv_b, YP, b2, tid);
    }
    SEAM(2);
    if (IN(3)) {
        pg8::Gemm g{YP, WoutT, T, D, D}; pg8::StaticOrder S; S.init(T, D, G, blk);
        EpiH2 E{x, args.out, H2B, rowss};
        pg8::gemm_phase<EpiH2, pg8::StaticOrder, true, true>(lds, g, S, E);
    }
    SEAM(3);
    if (IN(4)) {
        pg8::Gemm g{H2B, WqT, T, NQ, D}; pg8::StaticOrder S; S.init(T, NQ, G, blk);
        EpiQ E{Qb, rowss};
        pg8::gemm_phase<EpiQ, pg8::StaticOrder, true, true>(lds, g, S, E);
    }
    SEAM(4);
    if (IN(5)) {
#ifdef P5_SIMPLE
        for (int it = gw; it < T * 8; it += NGW) p5_simple(Qb, KB, SI, SG, it >> 3, it & 7, lane);
#else
        for (int it = gw; it < (T / 32) * 8; it += NGW) p5_item(Qb, KB, SI, SG, it >> 3, it & 7, lane);
#endif
    }
    SEAM(5);
    if (IN(6)) {
        for (int tok = gw; tok < T; tok += NGW) p6_token(H2B, rowss, SI, SG, UB, VB, gf, args.out, tok, lane);
    }
#undef IN
#undef SEAM
}

extern "C" void kernel_launch(void* const* d_in, const int* in_sizes, int n_in, void* d_out, int out_size, void* d_ws, size_t ws_size, hipStream_t stream) {
    static int grid = 0;
    if (grid == 0) {
        if (n_in != 15 || out_size != T * D || ws_size < WS_END) { fprintf(stderr, "kernel_launch: unexpected shapes: n_in %d out %d ws %zu (need %zu)\n", n_in, out_size, ws_size, (size_t)WS_END); grid = -1; return; }
        int dev = 0, cus = 0, per_cu = 0;
        if (hipGetDevice(&dev) != hipSuccess || hipDeviceGetAttribute(&cus, hipDeviceAttributeMultiprocessorCount, dev) != hipSuccess) { grid = -1; return; }
        if (hipFuncSetAttribute((const void*)fwd_kernel, hipFuncAttributeMaxDynamicSharedMemorySize, LDS_BYTES) != hipSuccess) { fprintf(stderr, "kernel_launch: hipFuncSetAttribute failed\n"); grid = -1; return; }
        if (hipOccupancyMaxActiveBlocksPerMultiprocessor(&per_cu, (const void*)fwd_kernel, NWAVES * 64, LDS_BYTES) != hipSuccess || per_cu < 1) fprintf(stderr, "kernel_launch: occupancy query says %d\n", per_cu);
        (void)hipGetLastError();
        grid = cus;
    }
    if (grid < 0) return;
    (void)hipMemsetAsync((char*)d_ws + WS_CTL, 0, CTL_ZERO_BYTES, stream);
    Args a{};
    for (int i = 0; i < 15; ++i) a.in[i] = (const float*)d_in[i];
    a.out = (float*)d_out; a.ws = (unsigned char*)d_ws;
#if MK_N_LAUNCHES == 1
    a.ph_lo = 0; a.ph_hi = NPHASE;
    hipLaunchKernelGGL(fwd_kernel, dim3(grid), dim3(NWAVES * 64), LDS_BYTES, stream, a);
#else
    for (int li = 0; li < NPHASE; ++li) { a.ph_lo = li; a.ph_hi = li + 1;
        hipLaunchKernelGGL(fwd_kernel, dim3(grid), dim3(NWAVES * 64), LDS_BYTES, stream, a); }
#endif
}
```

```cpp
#include <hip/hip_runtime.h>
#include <cstdio>
#include <cstdint>
namespace pg8 {
#define PG8_LAS __attribute__((address_space(3)))
typedef unsigned short bf16_t;
typedef short bf16x8 __attribute__((ext_vector_type(8)));
typedef float f32x4 __attribute__((ext_vector_type(4)));
typedef unsigned u32x4 __attribute__((ext_vector_type(4)));
constexpr int BM = 256, BK = 64, HALF = 128, HTB = HALF * BK * 2  , STAGE_BYTES = 8 * HTB, NXCD = 8, WGM = 8;

__host__ __device__ __forceinline__ int lds_byte(int r, int c) { const int st = (r >> 4) * 2 + (c >> 5), rr = r & 15, cc = c & 31, ob = rr * 64 + cc * 2; return st * 1024 + (ob ^ (((ob >> 9) & 1) << 5)); }
__host__ __device__ __forceinline__ void stage_rc(int b, int& R, int& C) { const int st = b / 1024, sb = b % 1024, swz = sb ^ (((sb >> 9) & 1) << 5); R = (st >> 1) * 16 + swz / 64; C = (st & 1) * 32 + (swz % 64) / 2; }
__host__ __device__ __forceinline__ int perm32(int rho) { const int n = rho >> 4, i = rho & 15; return 8 * (i >> 2) + 4 * n + (i & 3); }

struct Unit { int pm, pn; };
struct Gemm { const bf16_t* A; const bf16_t* Bt; int M, N, K; };

struct StaticOrder {
    int nM, nN, nwg, G, c;
    __host__ __device__ void init(int M, int N, int G_, int c_) { nM = M / BM; nN = N / BM; nwg = nM * nN; G = G_; c = c_; }
    __host__ __device__ bool next(int i, Unit& u) const {
        const long L = (long)i * G + c; if (L >= nwg) return false;
        int wgid = (int)L; { const int q = nwg / NXCD, r = nwg % NXCD, xcd = wgid % NXCD, off = wgid / NXCD; wgid = (xcd < r ? xcd * (q + 1) : r * (q + 1) + (xcd - r) * q) + off; }
        const int nig = WGM * nN, gid = wgid / nig, fm = gid * WGM, gsz = (nM - fm) < WGM ? (nM - fm) : WGM;
        u.pm = fm + ((wgid % nig) % gsz); u.pn = (wgid % nig) / gsz; return true;
    }
    __device__ __forceinline__ void a_ready(const Unit&) const {}
    __device__ __forceinline__ void done(const Unit&) const {}
};

__device__ __forceinline__ unsigned cvt_pk_bf16(float lo, float hi) { unsigned r; asm volatile("v_cvt_pk_bf16_f32 %0, %1, %2" : "=v"(r) : "v"(lo), "v"(hi)); return r; }
template <class Epi, class Sched, bool ALIGN_EPI = false, bool SP2 = false>
__device__ __forceinline__ void gemm_phase(PG8_LAS unsigned char* lds, const Gemm g, const Sched& S, const Epi& E) {
    const int tid = threadIdx.x, wid = __builtin_amdgcn_readfirstlane(tid >> 6), lane = tid & 63, wr = wid >> 2, wc = wid & 3, fr = lane & 15, fq = lane >> 4;
    const int K = g.K, nt = K / BK;
    unsigned voffA[2], voffB[2];
#pragma unroll
    for (int i = 0; i < 2; ++i) { int R, C; stage_rc(tid * 16 + i * 8192, R, C); const int Rb = Epi::PERM ? ((R & ~31) + perm32(R & 31)) : R;
        voffA[i] = (unsigned)(R * K + C) * 2u; voffB[i] = (unsigned)(Rb * K + C) * 2u; }
    const size_t kstep = (size_t)(BK * 2);
    const size_t hstep = (size_t)HALF * K * 2;
    const size_t tstep = 2 * hstep;
    const unsigned ldsw = (unsigned)wid * 1024u;
    const int aoff = lds_byte(wr * 64 + fr, fq * 8), boff = lds_byte(wc * 32 + fr, fq * 8);
#define PG8_SA(b, h) (((b) * 2 + (h)) * HTB)
#define PG8_SB(b, h) ((4 + (b) * 2 + (h)) * HTB)
#define PG8_STAGE(bufoff, gbase, voff) do { _Pragma("unroll") for (int _i = 0; _i < 2; ++_i) \
        __builtin_amdgcn_global_load_lds((const unsigned*)((const char*)(gbase) + (voff)[_i]), (PG8_LAS unsigned*)(lds + (bufoff) + ldsw + _i * 8192), 16, 0, 0); } while (0)
#define PG8_LDA(dst, b, h) do { _Pragma("unroll") for (int m = 0; m < 4; ++m) _Pragma("unroll") for (int k = 0; k < 2; ++k) dst[m][k] = *(const PG8_LAS bf16x8*)(lds + PG8_SA(b, h) + aoff + m * 2048 + k * 1024); } while (0)
#define PG8_LDB(dst, b, h) do { _Pragma("unroll") for (int n = 0; n < 2; ++n) _Pragma("unroll") for (int k = 0; k < 2; ++k) dst[n][k] = *(const PG8_LAS bf16x8*)(lds + PG8_SB(b, h) + boff + n * 2048 + k * 1024); } while (0)
#define PG8_MMA(ai, bj, At, Bt) do { __builtin_amdgcn_s_setprio(1); _Pragma("unroll") for (int m = 0; m < 4; ++m) _Pragma("unroll") for (int n = 0; n < 2; ++n) _Pragma("unroll") for (int k = 0; k < 2; ++k) \
        acc[ai][bj][m][n] = __builtin_amdgcn_mfma_f32_16x16x32_bf16(Bt[n][k], At[m][k], acc[ai][bj][m][n], 0, 0, 0); __builtin_amdgcn_s_setprio(0); } while (0)
#define PG8_WAIT_V(n) asm volatile("s_waitcnt vmcnt(" #n ")" ::: "memory")
#define PG8_WAIT_L(n) asm volatile("s_waitcnt lgkmcnt(" #n ")" ::: "memory")
#define PG8_BAR __builtin_amdgcn_s_barrier()
#define PG8_SCHED __builtin_amdgcn_sched_barrier(0)
    Unit cur, nxt; int ui = 0;
    if (!S.next(0, cur)) return;
    f32x4 acc[2][2][4][2];
#pragma unroll
    for (int a = 0; a < 2; ++a)
#pragma unroll
        for (int b = 0; b < 2; ++b)
#pragma unroll
            for (int m = 0; m < 4; ++m)
#pragma unroll
                for (int n = 0; n < 2; ++n) acc[a][b][m][n] = (f32x4){0.f, 0.f, 0.f, 0.f};
    bf16x8 At[4][2], B0[2][2], B1[2][2];
    const char* cA = (const char*)g.A + (size_t)cur.pm * tstep; const char* cB = (const char*)g.Bt + (size_t)cur.pn * tstep;
    S.a_ready(cur);
    if constexpr (SP2) {
        PG8_STAGE(PG8_SB(0, 0), cB, voffB); PG8_STAGE(PG8_SB(0, 1), cB + hstep, voffB); PG8_STAGE(PG8_SA(0, 0), cA, voffA); PG8_STAGE(PG8_SA(0, 1), cA + hstep, voffA);
        if (wr == 1) PG8_BAR;
        PG8_WAIT_V(2); PG8_BAR;
        PG8_STAGE(PG8_SB(1, 0), cB + kstep, voffB); PG8_STAGE(PG8_SA(1, 0), cA + kstep, voffA); PG8_STAGE(PG8_SB(1, 1), cB + hstep + kstep, voffB);
        PG8_WAIT_V(6); PG8_BAR;
    } else {
        PG8_STAGE(PG8_SB(0, 0), cB, voffB); PG8_STAGE(PG8_SA(0, 0), cA, voffA); PG8_STAGE(PG8_SB(0, 1), cB + hstep, voffB); PG8_STAGE(PG8_SA(0, 1), cA + hstep, voffA);
        if (wr == 1) PG8_BAR;
        PG8_WAIT_V(4); PG8_BAR;
        PG8_STAGE(PG8_SB(1, 0), cB + kstep, voffB); PG8_STAGE(PG8_SA(1, 0), cA + kstep, voffA); PG8_STAGE(PG8_SB(1, 1), cB + hstep + kstep, voffB);
        PG8_WAIT_V(6); PG8_BAR;
    }
    for (;;) {
        const bool has_next = S.next(ui + 1, nxt);
        const char* nA = has_next ? (const char*)g.A + (size_t)nxt.pm * tstep : cA; const char* nB = has_next ? (const char*)g.Bt + (size_t)nxt.pn * tstep : cB;
        for (int t = 0; t < nt; t += 2) {
            const bool last = (t == nt - 2);
            const char* a1 = cA + (size_t)(t + 1) * kstep;
            const char* a2 = last ? nA : cA + (size_t)(t + 2) * kstep; const char* b2 = last ? nB : cB + (size_t)(t + 2) * kstep;
            const char* a3 = a2 + kstep; const char* b3 = b2 + kstep;
            if (last && has_next) S.a_ready(nxt);
            if constexpr (SP2) {
            PG8_LDB(B0, 0, 0); PG8_LDB(B1, 0, 1); PG8_SCHED; PG8_LDA(At, 0, 0); PG8_STAGE(PG8_SA(1, 1), a1 + hstep, voffA);
            PG8_WAIT_V(8); PG8_WAIT_L(0); PG8_BAR; PG8_MMA(0, 0, At, B0); PG8_MMA(0, 1, At, B1); PG8_BAR; PG8_SCHED;
            PG8_LDA(At, 0, 1); PG8_STAGE(PG8_SB(0, 0), b2, voffB); PG8_STAGE(PG8_SB(0, 1), b2 + hstep, voffB); PG8_STAGE(PG8_SA(0, 0), a2, voffA);
            PG8_WAIT_V(8); PG8_WAIT_L(0); PG8_BAR; PG8_MMA(1, 0, At, B0); PG8_MMA(1, 1, At, B1); PG8_BAR; PG8_SCHED;
            PG8_LDB(B0, 1, 0); PG8_LDB(B1, 1, 1); PG8_SCHED; PG8_LDA(At, 1, 0); PG8_STAGE(PG8_SA(0, 1), a2 + hstep, voffA);
            PG8_WAIT_V(8); PG8_WAIT_L(0); PG8_BAR; PG8_MMA(0, 0, At, B0); PG8_MMA(0, 1, At, B1); PG8_BAR; PG8_SCHED;
            PG8_LDA(At, 1, 1); PG8_STAGE(PG8_SB(1, 0), b3, voffB); PG8_STAGE(PG8_SB(1, 1), b3 + hstep, voffB); PG8_STAGE(PG8_SA(1, 0), a3, voffA);
            PG8_WAIT_V(8); PG8_WAIT_L(0); PG8_BAR; PG8_MMA(1, 0, At, B0); PG8_MMA(1, 1, At, B1); PG8_BAR; PG8_SCHED;
            } else {
            PG8_LDB(B0, 0, 0); PG8_SCHED; PG8_LDA(At, 0, 0); PG8_STAGE(PG8_SA(1, 1), a1 + hstep, voffA);
            PG8_WAIT_L(8); PG8_BAR; PG8_WAIT_L(0); PG8_MMA(0, 0, At, B0); PG8_BAR; PG8_SCHED;
            PG8_LDB(B1, 0, 1); PG8_STAGE(PG8_SB(0, 0), b2, voffB);
            PG8_BAR; PG8_WAIT_L(0); PG8_MMA(0, 1, At, B1); PG8_BAR;
            PG8_LDA(At, 0, 1); PG8_STAGE(PG8_SA(0, 0), a2, voffA);
            PG8_BAR; PG8_WAIT_L(0); PG8_MMA(1, 0, At, B0); PG8_BAR; PG8_SCHED;
            PG8_STAGE(PG8_SB(0, 1), b2 + hstep, voffB);
            PG8_WAIT_V(6); PG8_BAR; PG8_MMA(1, 1, At, B1); PG8_BAR;
            PG8_LDB(B0, 1, 0); PG8_SCHED; PG8_LDA(At, 1, 0); PG8_STAGE(PG8_SA(0, 1), a2 + hstep, voffA);
            PG8_WAIT_L(8); PG8_BAR; PG8_WAIT_L(0); PG8_MMA(0, 0, At, B0); PG8_BAR; PG8_SCHED;
            PG8_LDB(B1, 1, 1); PG8_STAGE(PG8_SB(1, 0), b3, voffB);
            PG8_BAR; PG8_WAIT_L(0); PG8_MMA(0, 1, At, B1); PG8_BAR;
            PG8_LDA(At, 1, 1); PG8_STAGE(PG8_SA(1, 0), a3, voffA);
            PG8_BAR; PG8_WAIT_L(0); PG8_MMA(1, 0, At, B0); PG8_BAR; PG8_SCHED;
            PG8_STAGE(PG8_SB(1, 1), b3 + hstep, voffB);
            PG8_WAIT_V(6); PG8_BAR; PG8_MMA(1, 1, At, B1); PG8_BAR;
            }
        }
        if constexpr (ALIGN_EPI) { if (wr == 0) PG8_BAR; }
        if constexpr (!Epi::AFTER_DRAIN) { E(acc, cur, wr, wc, fr, fq); S.done(cur); }
        if (!has_next) break;
#pragma unroll
        for (int a = 0; a < 2; ++a)
#pragma unroll
            for (int b = 0; b < 2; ++b)
#pragma unroll
                for (int m = 0; m < 4; ++m)
#pragma unroll
                    for (int n = 0; n < 2; ++n) acc[a][b][m][n] = (f32x4){0.f, 0.f, 0.f, 0.f};
        cur = nxt; cA = nA; cB = nB; ++ui;
        if constexpr (ALIGN_EPI) { if (wr == 1) PG8_BAR; }
    }
    PG8_WAIT_V(0);
    if constexpr (!ALIGN_EPI) { if (wr == 0) PG8_BAR; }
    PG8_BAR;
    if constexpr (Epi::AFTER_DRAIN) { E.fused(acc, cur, wr, wc, fr, fq, lds, wid, lane); S.done(cur); }
#undef PG8_SA
#undef PG8_SB
#undef PG8_STAGE
#undef PG8_LDA
#undef PG8_LDB
#undef PG8_MMA
#undef PG8_WAIT_V
#undef PG8_WAIT_L
#undef PG8_BAR
#undef PG8_SCHED
}
}

#define GAS __attribute__((address_space(1)))
#define LAS __attribute__((address_space(3)))
#define XB_TMO      128
#define XB_XCNT(j)  (256  + 64 * (j))
#define XB_XSUB(j)  (1280 + 64 * (j))
#define XB_XGEN(j)  (2304 + 64 * (j))
#define XB_TOP      3328
#define XB_TOPGEN   3392
#define XCD_BAR_WORDS 3456
#define XB_SPIN_CAP (1u << 18)

__device__ __forceinline__ unsigned xb_ld(unsigned* p)              { return __hip_atomic_load(p, __ATOMIC_RELAXED, __HIP_MEMORY_SCOPE_AGENT); }
__device__ __forceinline__ unsigned xb_add(unsigned* p, unsigned v) { return __hip_atomic_fetch_add(p, v, __ATOMIC_RELAXED, __HIP_MEMORY_SCOPE_AGENT); }
__device__ __forceinline__ unsigned xb_xcc_id() { return (unsigned)__builtin_amdgcn_s_getreg((3 << 11) | 20) & 0xFu; }
#define XB_SPIN(cond, bar) do { unsigned _sp = 0; while (cond) { __builtin_amdgcn_s_sleep(1); \
    if ((++_sp & 255u) == 0u) { if (xb_ld(&(bar)[XB_TMO])) break; if (_sp > XB_SPIN_CAP) { atomicAdd(&(bar)[XB_TMO], 1u); break; } } } } while (0)

struct XcdBarrier {
    unsigned* bar; unsigned x;
    volatile LAS unsigned* st;
};

__device__ __forceinline__ XcdBarrier xcd_barrier_post(unsigned* bar, volatile LAS unsigned* st) {
    XcdBarrier b; b.bar = bar; b.x = xb_xcc_id(); b.st = st;
    if (threadIdx.x == 0) (void)xb_add(&bar[XB_XCNT(b.x)], 1u);
    return b;
}
__device__ __forceinline__ void xcd_barrier_complete(unsigned* bar, unsigned x, unsigned& nloc, unsigned& nx) {
    const unsigned G = gridDim.x * gridDim.y * gridDim.z;
    unsigned sum, cnt, mine, sp = 0u;
    for (;;) {
        sum = 0u; cnt = 0u; mine = 0u;
#pragma unroll
        for (unsigned j = 0; j < 16; ++j) { const unsigned c = xb_ld(&bar[XB_XCNT(j)]); sum += c; cnt += (c > 0u) ? 1u : 0u; mine = (j == x) ? c : mine; }
        if (sum == G) break;
        __builtin_amdgcn_s_sleep(1);
        if ((++sp & 255u) == 0u) { if (xb_ld(&bar[XB_TMO])) break; if (sp > XB_SPIN_CAP) { atomicAdd(&bar[XB_TMO], 1u); break; } }
    }
    nloc = mine > 0u ? mine : 1u; nx = cnt > 0u ? cnt : 1u;
}

__device__ __forceinline__ void xcd_barrier(const XcdBarrier& b) {
    asm volatile("s_waitcnt vmcnt(0)" ::: "memory");
    __syncthreads();
    if (threadIdx.x == 0) {
        unsigned* bar = b.bar;
        __builtin_amdgcn_s_waitcnt(0);
        unsigned nloc = b.st[0], nx = b.st[1];
        if (nloc == 0u) { xcd_barrier_complete(bar, b.x, nloc, nx); b.st[0] = nloc; b.st[1] = nx; }
        const unsigned old = xb_add(&bar[XB_XSUB(b.x)], 1u);
        const unsigned gen = old / nloc;
        if (old + 1u == (gen + 1u) * nloc) {
            __builtin_amdgcn_fence(__ATOMIC_RELEASE, "agent");
            asm volatile("s_waitcnt vmcnt(0)" ::: "memory");
            const unsigned og = xb_add(&bar[XB_TOP], 1u);
            const unsigned tg = og / nx;
            if (og + 1u == (tg + 1u) * nx) xb_add(&bar[XB_TOPGEN], 1u);
            else XB_SPIN(xb_ld(&bar[XB_TOPGEN]) == tg, bar);
            __builtin_amdgcn_fence(__ATOMIC_ACQUIRE, "agent");
            xb_add(&bar[XB_XGEN(b.x)], 1u);
            asm volatile("s_waitcnt vmcnt(0)" ::: "memory");
        } else {
            XB_SPIN(xb_ld(&bar[XB_XGEN(b.x)]) == gen, bar);
            __builtin_amdgcn_fence(__ATOMIC_ACQUIRE, "agent");
            asm volatile("s_waitcnt vmcnt(0)" ::: "memory");
        }
    }
    __syncthreads();
}

constexpr int D = 1024, BATCH = 4, SEQ = 8192, NMETA = 16, LSEQ = SEQ + NMETA;
constexpr int T = BATCH * SEQ;
constexpr int NP = 2048, NQ = 2048, NEXP = 16384;
constexpr float EPS = 1e-6f;
constexpr int NWAVES = 8;

constexpr size_t MiB = 1u << 20;
constexpr size_t WS_CTL = 0, CTL_ZERO_BYTES = 1 * MiB;
constexpr int CW_BAR = 4096;
constexpr size_t WS_ROWSS = 512 * 1024;
constexpr size_t WS_WIN = 2 * MiB, WS_WOUT = 6 * MiB, WS_WQ = 8 * MiB, WS_KEYS = 12 * MiB, WS_RSTD1 = 13 * MiB;
constexpr size_t WS_UB = 16 * MiB, WS_VB = 48 * MiB, WS_XB = 80 * MiB  , WS_P = 144 * MiB  ;
constexpr size_t WS_H2B = 274 * MiB, WS_SELI = 338 * MiB, WS_SELG = 354 * MiB, WS_END = 370 * MiB;

constexpr int RING_BYTES = 131072, MISC_OFF = RING_BYTES + 320, LDS_BYTES = 147456;

typedef unsigned short bf16;
typedef unsigned v4u __attribute__((ext_vector_type(4)));
typedef unsigned v2u __attribute__((ext_vector_type(2)));
typedef float f32x4 __attribute__((ext_vector_type(4)));
typedef float f32x16 __attribute__((ext_vector_type(16)));
typedef short bf16x8 __attribute__((ext_vector_type(8)));
typedef __bf16 bf16x2_t __attribute__((ext_vector_type(2)));
#define LDS_WAIT() asm volatile("s_waitcnt lgkmcnt(0)" ::: "memory")

__device__ __forceinline__ unsigned f2bf(float f) { unsigned u = __builtin_bit_cast(unsigned, f); return (u + 0x7fffu + ((u >> 16) & 1u)) >> 16; }
__device__ __forceinline__ unsigned pk2(float lo, float hi) { return f2bf(lo) | (f2bf(hi) << 16); }
__device__ __forceinline__ float bflo(unsigned w) { return __builtin_bit_cast(float, w << 16); }
__device__ __forceinline__ float bfhi(unsigned w) { return __builtin_bit_cast(float, w & 0xffff0000u); }
__device__ __forceinline__ float wave_sum(float v) {
#pragma unroll
    for (int o = 1; o < 64; o <<= 1) v += __shfl_xor(v, o);
    return v;
}

struct EpiP {
    static constexpr bool PERM = true, AFTER_DRAIN = false;
    bf16* P; const float* rstd;
    __device__ __forceinline__ void operator()(const pg8::f32x4 (&acc)[2][2][4][2], const pg8::Unit& u, int wr, int wc, int fr, int fq) const {
        const int row0 = u.pm * 256 + wr * 64 + fr, col0 = u.pn * 256 + wc * 32 + 8 * fq;
#pragma unroll
        for (int ai = 0; ai < 2; ++ai)
#pragma unroll
            for (int m = 0; m < 4; ++m) {
                const int row = row0 + ai * 128 + m * 16; const float rs = rstd[row];
                bf16* rowp = P + ((size_t)(row >> 13) * LSEQ + NMETA + (row & 8191)) * NP + col0;
#pragma unroll
                for (int bj = 0; bj < 2; ++bj) { const pg8::f32x4 v0 = acc[ai][bj][m][0] * rs, v1 = acc[ai][bj][m][1] * rs;
                    v4u w; w.x = pg8::cvt_pk_bf16(v0[0], v0[1]); w.y = pg8::cvt_pk_bf16(v0[2], v0[3]); w.z = pg8::cvt_pk_bf16(v1[0], v1[1]); w.w = pg8::cvt_pk_bf16(v1[2], v1[3]);
                    *(v4u*)(rowp + bj * 128) = w; }
            }
    }
};
struct EpiH2 {
    static constexpr bool PERM = true, AFTER_DRAIN = false;
    const float* X; float* H2; bf16* H2B; float* rowss;
    __device__ __forceinline__ void operator()(const pg8::f32x4 (&acc)[2][2][4][2], const pg8::Unit& u, int wr, int wc, int fr, int fq) const {
        const int row0 = u.pm * 256 + wr * 64 + fr, col0 = u.pn * 256 + wc * 32 + 8 * fq;
#pragma unroll
        for (int ai = 0; ai < 2; ++ai)
#pragma unroll
            for (int m = 0; m < 4; ++m) {
                const int row = row0 + ai * 128 + m * 16; const size_t off = (size_t)row * D + col0; float ss = 0.f;
#pragma unroll
                for (int bj = 0; bj < 2; ++bj) {
                    const pg8::f32x4 x0 = *(const pg8::f32x4*)(X + off + bj * 128), x1 = *(const pg8::f32x4*)(X + off + bj * 128 + 4);
                    const pg8::f32x4 v0 = acc[ai][bj][m][0] + x0, v1 = acc[ai][bj][m][1] + x1;
                    *(pg8::f32x4*)(H2 + off + bj * 128) = v0; *(pg8::f32x4*)(H2 + off + bj * 128 + 4) = v1;
                    v4u w; w.x = pg8::cvt_pk_bf16(v0[0], v0[1]); w.y = pg8::cvt_pk_bf16(v0[2], v0[3]); w.z = pg8::cvt_pk_bf16(v1[0], v1[1]); w.w = pg8::cvt_pk_bf16(v1[2], v1[3]);
                    *(v4u*)(H2B + off + bj * 128) = w;
                    ss += (v0[0] * v0[0] + v0[1] * v0[1]) + (v0[2] * v0[2] + v0[3] * v0[3]) + (v1[0] * v1[0] + v1[1] * v1[1]) + (v1[2] * v1[2] + v1[3] * v1[3]);
                }
                ss += __shfl_xor(ss, 16); ss += __shfl_xor(ss, 32);
                if (fq == 0) atomicAdd(rowss + row, ss);
            }
    }
};
struct EpiQ {
    static constexpr bool PERM = true, AFTER_DRAIN = false;
    bf16* Q; const float* rowss;
    __device__ __forceinline__ void operator()(const pg8::f32x4 (&acc)[2][2][4][2], const pg8::Unit& u, int wr, int wc, int fr, int fq) const {
        const int row0 = u.pm * 256 + wr * 64 + fr, col0 = u.pn * 256 + wc * 32 + 8 * fq;
#pragma unroll
        for (int ai = 0; ai < 2; ++ai)
#pragma unroll
            for (int m = 0; m < 4; ++m) {
                const int row = row0 + ai * 128 + m * 16; const float rs = rsqrtf(rowss[row] * (1.0f / D) + EPS);
                bf16* rowp = Q + (size_t)row * NQ + col0;
#pragma unroll
                for (int bj = 0; bj < 2; ++bj) { const pg8::f32x4 v0 = acc[ai][bj][m][0] * rs, v1 = acc[ai][bj][m][1] * rs;
                    v4u w; w.x = pg8::cvt_pk_bf16(v0[0], v0[1]); w.y = pg8::cvt_pk_bf16(v0[2], v0[3]); w.z = pg8::cvt_pk_bf16(v1[0], v1[1]); w.w = pg8::cvt_pk_bf16(v1[2], v1[3]);
                    *(v4u*)(rowp + bj * 128) = w; }
            }
    }
};

__device__ __forceinline__ void row_to_bf16(const float* src, bf16* dst, const float* gain, float* rstd_out, int lane) {
    const f32x4* xr = (const f32x4*)src + lane;
    f32x4 v[4]; float s = 0.f;
#pragma unroll
    for (int j = 0; j < 4; ++j) { v[j] = xr[64 * j]; s += (v[j].x * v[j].x + v[j].y * v[j].y) + (v[j].z * v[j].z + v[j].w * v[j].w); }
    if (rstd_out) { s = wave_sum(s); if (lane == 0) *rstd_out = rsqrtf(s * (1.0f / D) + EPS); }
    if (gain) {
#pragma unroll
        for (int j = 0; j < 4; ++j) v[j] = v[j] * ((const f32x4*)gain)[lane + 64 * j];
    }
    unsigned long long* o8 = (unsigned long long*)dst + lane;
#pragma unroll
    for (int j = 0; j < 4; ++j) o8[64 * j] = (unsigned long long)pk2(v[j].x, v[j].y) | ((unsigned long long)pk2(v[j].z, v[j].w) << 32);
}
__device__ __forceinline__ void p0_transpose_item(const float* W, int K, int N, const float* gain, bf16* WT, LAS float* scr, int item, int lane) {
    const int nblk = N / 32, kb = item / nblk, nb = item % nblk, k0 = 64 * kb, n0 = 32 * nb;
#pragma unroll 8
    for (int i = 0; i < 32; ++i) { const int kk = 2 * i + (lane >> 5); const float gk = gain ? gain[k0 + kk] : 1.0f; scr[kk * 33 + (lane & 31)] = W[(size_t)(k0 + kk) * N + n0 + (lane & 31)] * gk; }
    LDS_WAIT(); asm volatile("" ::: "memory");
    const int c = lane & 7;
#pragma unroll
    for (int j = 0; j < 4; ++j) { const int n = (lane >> 3) + 8 * j; const LAS float* s = scr + (8 * c) * 33 + n;
        v4u o; o.x = pk2(s[0 * 33], s[1 * 33]); o.y = pk2(s[2 * 33], s[3 * 33]); o.z = pk2(s[4 * 33], s[5 * 33]); o.w = pk2(s[6 * 33], s[7 * 33]);
        *(v4u*)(WT + (size_t)(n0 + n) * K + k0 + 8 * c) = o; }
    LDS_WAIT(); asm volatile("" ::: "memory");
}
__device__ __forceinline__ void p0_weff_item(const float* w_out, const float* pool_w, const float* pool_scale, bf16* WoutT, int item, int lane) {
    const int nb = item & 15, cg = (item >> 4) & 15, g = item >> 8;
    const int n = nb * 64 + lane;
    float acc[8];
#pragma unroll
    for (int i = 0; i < 8; ++i) acc[i] = 0.f;
    const float* wo = w_out + (size_t)(512 + g * 128) * D + n;
    const float* pw = pool_w + (size_t)(g * 128 + cg * 8) * 128;
    const float* ps = pool_scale + g * 128;
#pragma unroll 4
    for (int d = 0; d < 128; ++d) { const float w = wo[(size_t)d * D] * ps[d];
#pragma unroll
        for (int i = 0; i < 8; ++i) acc[i] += pw[i * 128 + d] * w; }
    v4u o; o.x = pk2(acc[0], acc[1]); o.y = pk2(acc[2], acc[3]); o.z = pk2(acc[4], acc[5]); o.w = pk2(acc[6], acc[7]);
    *(v4u*)(WoutT + (size_t)n * D + 512 + g * 128 + cg * 8) = o;
}
__device__ __forceinline__ void p0_meta(const float* meta, const float* g1, const float* w_in, bf16* P, LAS unsigned char* lds, int blk, int tid) {
    LAS float* mg = (LAS float*)lds;
    LAS float* part = (LAS float*)(lds + 65536);
    LAS float* rs = (LAS float*)(lds + 65536 + 32768);
    const int wave = tid >> 6, lane = tid & 63;
    for (int i = tid; i < 16 * 1024; i += 512) mg[i] = meta[i] * g1[i & 1023];
#pragma unroll
    for (int jj = 0; jj < 2; ++jj) { const int j = wave * 2 + jj; float s = 0.f;
        for (int k = lane; k < 1024; k += 64) { const float v = meta[j * 1024 + k]; s += v * v; }
        s = wave_sum(s); if (lane == 0) rs[j] = rsqrtf(s * (1.0f / D) + EPS); }
    __syncthreads();
    const int nn = tid & 7, kq = tid >> 3;
    float acc[16];
#pragma unroll
    for (int j = 0; j < 16; ++j) acc[j] = 0.f;
#pragma unroll 4
    for (int kk = 0; kk < 16; ++kk) { const int k = 16 * kq + kk; const float w = w_in[(size_t)k * NP + 8 * blk + nn];
#pragma unroll
        for (int j = 0; j < 16; ++j) acc[j] += mg[j * 1024 + k] * w; }
#pragma unroll
    for (int j = 0; j < 16; ++j) part[(kq * 16 + j) * 8 + nn] = acc[j];
    __syncthreads();
    if (tid < 128) { const int j = tid >> 3; float s = 0.f;
        for (int q = 0; q < 64; ++q) s += part[(q * 16 + j) * 8 + nn];
        const bf16 o = (bf16)f2bf(s * rs[j]);
#pragma unroll
        for (int b = 0; b < BATCH; ++b) P[((size_t)b * LSEQ + j) * NP + 8 * blk + nn] = o; }
    __syncthreads();
}

__device__ __forceinline__ void ld8(const bf16* p, float (&f)[8]) {
    const v4u w = *(const v4u*)p;
    f[0] = bflo(w.x); f[1] = bfhi(w.x); f[2] = bflo(w.y); f[3] = bfhi(w.y); f[4] = bflo(w.z); f[5] = bfhi(w.z); f[6] = bflo(w.w); f[7] = bfhi(w.w);
}
__device__ __forceinline__ void st8(bf16* p, const float (&f)[8]) {
    v4u o; o.x = pk2(f[0], f[1]); o.y = pk2(f[2], f[3]); o.z = pk2(f[4], f[5]); o.w = pk2(f[6], f[7]); *(v4u*)p = o;
}
__device__ __forceinline__ void p2_convpool(const bf16* P, const float* conv_w, const float* conv_b, bf16* Y, int blk, int tid) {
    const int cgp = tid & 127, run = tid >> 7;
    const int r_start = blk * 128 + run * 32;
    const int b = r_start >> 13, l0 = NMETA + (r_start & 8191);
    const bf16* Pb = P + (size_t)b * LSEQ * NP;
    if (cgp < 64) {
        const int c0 = cgp * 8;
        float w0[8], w1[8], w2[8], cb[8];
#pragma unroll
        for (int i = 0; i < 8; ++i) { w0[i] = conv_w[c0 + i]; w1[i] = conv_w[512 + c0 + i]; w2[i] = conv_w[1024 + c0 + i]; cb[i] = conv_b[c0 + i]; }
        float zp[8], zc[8], zn[8], a[8], c[8], bg[8], y[8];
        ld8(Pb + (size_t)(l0 - 1) * NP + c0, a); ld8(Pb + (size_t)(l0 - 1) * NP + 1024 + c0, c);
#pragma unroll
        for (int i = 0; i < 8; ++i) zp[i] = a[i] * c[i];
        ld8(Pb + (size_t)l0 * NP + c0, a); ld8(Pb + (size_t)l0 * NP + 1024 + c0, c);
#pragma unroll
        for (int i = 0; i < 8; ++i) zc[i] = a[i] * c[i];
        for (int t = 0; t < 32; ++t) { const int l = l0 + t;
            if (l + 1 < LSEQ) { ld8(Pb + (size_t)(l + 1) * NP + c0, a); ld8(Pb + (size_t)(l + 1) * NP + 1024 + c0, c);
#pragma unroll
                for (int i = 0; i < 8; ++i) zn[i] = a[i] * c[i]; }
            else {
#pragma unroll
                for (int i = 0; i < 8; ++i) zn[i] = 0.f; }
            ld8(Pb + (size_t)l * NP + 512 + c0, bg);
#pragma unroll
            for (int i = 0; i < 8; ++i) { y[i] = bg[i] * (w0[i] * zp[i] + w1[i] * zc[i] + w2[i] * zn[i] + cb[i]); zp[i] = zc[i]; zc[i] = zn[i]; }
            st8(Y + (size_t)(r_start + t) * D + c0, y); }
    } else {
        const int c0 = (cgp - 64) * 8, g = c0 >> 7, hw = 1 << g;
        const bf16* Hb = Pb + 1536 + c0;
        float S[8], v[8], m[8];
#pragma unroll
        for (int i = 0; i < 8; ++i) S[i] = 0.f;
        { const int hi0 = (l0 + hw < LSEQ) ? l0 + hw : LSEQ;
          for (int j = l0 - hw; j < hi0; ++j) { ld8(Hb + (size_t)j * NP, v);
#pragma unroll
              for (int i = 0; i < 8; ++i) S[i] += v[i]; } }
        for (int t = 0; t < 32; ++t) { const int l = l0 + t; const int hi = (l + hw < LSEQ) ? l + hw : LSEQ; const float inv = 1.0f / (float)(hi - (l - hw));
            ld8(Hb + (size_t)l * NP, v);
#pragma unroll
            for (int i = 0; i < 8; ++i) m[i] = S[i] * inv - v[i];
            st8(Y + (size_t)(r_start + t) * D + 512 + c0, m);
            ld8(Hb + (size_t)(l - hw) * NP, v);
#pragma unroll
            for (int i = 0; i < 8; ++i) S[i] -= v[i];
            if (l + hw < LSEQ) { ld8(Hb + (size_t)(l + hw) * NP, v);
#pragma unroll
                for (int i = 0; i < 8; ++i) S[i] += v[i]; } }
    }
}

#define MFMA32(a, b, c) __builtin_amdgcn_mfma_f32_32x32x16_bf16((a), (b), (c), 0, 0, 0)
__device__ __forceinline__ float mkcand(float a, float b, unsigned tag) { return __builtin_bit_cast(float, (__builtin_bit_cast(unsigned, a + b) & ~0xFFu) | tag); }
__device__ __forceinline__ unsigned keylook(unsigned long long lo, unsigned long long hi, unsigned i) {
    const unsigned long long w = (i < 8u) ? lo : hi;
    return (unsigned)(w >> (8u * (i & 7u))) & 127u;
}
__device__ __forceinline__ void p5_item(const bf16* Q, const bf16* KB, int* SI, float* SG, int tg, int head, int lane) {
    const int r = lane & 31, h = lane >> 5;
    const int tok = tg * 32 + r;
    const float NEG = -__builtin_inff();
    float sv[2][16];
#pragma unroll
    for (int p = 0; p < 2; ++p) {
        const int hp = head * 2 + p;
        f32x16 acc[4];
#pragma unroll
        for (int kt = 0; kt < 4; ++kt)
#pragma unroll
            for (int i = 0; i < 16; ++i) acc[kt][i] = 0.f;
        const bf16* qrow = Q + (size_t)tok * NQ + hp * 128 + 8 * h;
        const bf16* kb = KB + ((size_t)hp * 128 + r) * 128 + 8 * h;
#pragma unroll 2
        for (int s = 0; s < 8; ++s) {
            const bf16x8 bq = *(const bf16x8*)(qrow + 16 * s);
#pragma unroll
            for (int kt = 0; kt < 4; ++kt) { const bf16x8 ak = *(const bf16x8*)(kb + (size_t)kt * 32 * 128 + 16 * s); acc[kt] = MFMA32(ak, bq, acc[kt]); }
        }
        __builtin_amdgcn_sched_barrier(0);
        float v[64];
#pragma unroll
        for (int kt = 0; kt < 4; ++kt)
#pragma unroll
            for (int i = 0; i < 16; ++i) { const unsigned key = 32u * kt + (i & 3) + 8u * (i >> 2) + 4u * h;
                const float av = acc[kt][i];
                v[kt * 16 + i] = __builtin_bit_cast(float, (__builtin_bit_cast(unsigned, av) & ~127u) | key); }
#pragma unroll
        for (int t = 0; t < 16; ++t) {
            float m = v[0];
#pragma unroll
            for (int i = 1; i < 64; ++i) m = fmaxf(m, v[i]);
            m = fmaxf(m, __shfl_xor(m, 32));
            sv[p][t] = m;
            const unsigned mb = __builtin_bit_cast(unsigned, m);
#pragma unroll
            for (int i = 0; i < 64; ++i) v[i] = (__builtin_bit_cast(unsigned, v[i]) == mb) ? NEG : v[i];
        }
        __builtin_amdgcn_sched_barrier(0);
    }
    float cv[50];
#define P5_CROW(I, NJ, BASE) _Pragma("unroll") for (int j = 0; j < NJ; ++j) cv[BASE + j] = mkcand(sv[0][I], sv[1][j], (unsigned)((I << 4) | j));
    P5_CROW(0, 16, 0) P5_CROW(1, 8, 16) P5_CROW(2, 5, 24) P5_CROW(3, 4, 29) P5_CROW(4, 3, 33) P5_CROW(5, 2, 36) P5_CROW(6, 2, 38) P5_CROW(7, 2, 40)
    P5_CROW(8, 1, 42) P5_CROW(9, 1, 43) P5_CROW(10, 1, 44) P5_CROW(11, 1, 45) P5_CROW(12, 1, 46) P5_CROW(13, 1, 47) P5_CROW(14, 1, 48) P5_CROW(15, 1, 49)
#undef P5_CROW
    unsigned long long K0lo = 0ull, K0hi = 0ull, K1lo = 0ull, K1hi = 0ull;
#pragma unroll
    for (int i = 0; i < 8; ++i) {
        K0lo |= (unsigned long long)(__builtin_bit_cast(unsigned, sv[0][i]) & 127u) << (8 * i); K0hi |= (unsigned long long)(__builtin_bit_cast(unsigned, sv[0][8 + i]) & 127u) << (8 * i);
        K1lo |= (unsigned long long)(__builtin_bit_cast(unsigned, sv[1][i]) & 127u) << (8 * i); K1hi |= (unsigned long long)(__builtin_bit_cast(unsigned, sv[1][8 + i]) & 127u) << (8 * i); }
    float sel[16];
#pragma unroll
    for (int t = 0; t < 16; ++t) {
        float m = cv[0];
#pragma unroll
        for (int i = 1; i < 50; ++i) m = fmaxf(m, cv[i]);
        sel[t] = m;
        const unsigned mb = __builtin_bit_cast(unsigned, m);
#pragma unroll
        for (int i = 0; i < 50; ++i) cv[i] = (__builtin_bit_cast(unsigned, cv[i]) == mb) ? NEG : cv[i];
    }
    float e[16], esum = 0.f; int eidx[16];
#pragma unroll
    for (int t = 0; t < 16; ++t) { e[t] = __expf(sel[t] - sel[0]); esum += e[t];
        const unsigned tag = __builtin_bit_cast(unsigned, sel[t]) & 0xFFu;
        eidx[t] = (int)(keylook(K0lo, K0hi, tag >> 4) * 128u + keylook(K1lo, K1hi, tag & 15u)); }
    const float inv = 1.0f / esum;
    if (h == 0) { int* o = SI + (size_t)tok * 128 + head * 16;
#pragma unroll
        for (int t = 0; t < 16; t += 4) *(int4*)(o + t) = make_int4(eidx[t], eidx[t + 1], eidx[t + 2], eidx[t + 3]); }
    else { float* o = SG + (size_t)tok * 128 + head * 16;
#pragma unroll
        for (int t = 0; t < 16; t += 4) *(f32x4*)(o + t) = (f32x4){e[t] * inv, e[t + 1] * inv, e[t + 2] * inv, e[t + 3] * inv}; }
}


__device__ __forceinline__ float wave_max(float v) {
#pragma unroll
    for (int o = 1; o < 64; o <<= 1) v = fmaxf(v, __shfl_xor(v, o));
    return v;
}
__device__ __forceinline__ float pick4(float a, float b, float c, float d, int k) { return (k < 2) ? ((k == 0) ? a : b) : ((k == 2) ? c : d); }
__device__ __forceinline__ void p5_simple(const bf16* Q, const bf16* KB, int* SI, float* SG, int tok, int head, int lane) {
    const float NEG = -__builtin_inff();
    float s[2][2];
#pragma unroll
    for (int p = 0; p < 2; ++p) { const int hp = head * 2 + p; const bf16* qrow = Q + (size_t)tok * NQ + hp * 128;
#pragma unroll
        for (int kk = 0; kk < 2; ++kk) { const unsigned key = lane + 64 * kk; const bf16* kr = KB + ((size_t)hp * 128 + key) * 128; float acc = 0.f;
            for (int d = 0; d < 128; d += 8) { float qf[8], kf[8]; ld8(qrow + d, qf); ld8(kr + d, kf);
#pragma unroll
                for (int i = 0; i < 8; ++i) acc += qf[i] * kf[i]; }
            s[p][kk] = __builtin_bit_cast(float, (__builtin_bit_cast(unsigned, acc) & ~127u) | key); } }
    float sv[2][16];
#pragma unroll
    for (int p = 0; p < 2; ++p)
#pragma unroll
        for (int t = 0; t < 16; ++t) { const float m = wave_max(fmaxf(s[p][0], s[p][1])); sv[p][t] = m; const unsigned mb = __builtin_bit_cast(unsigned, m);
            s[p][0] = (__builtin_bit_cast(unsigned, s[p][0]) == mb) ? NEG : s[p][0]; s[p][1] = (__builtin_bit_cast(unsigned, s[p][1]) == mb) ? NEG : s[p][1]; }
    const int j = lane & 15, ib = lane >> 4;
    float s1j = sv[1][0];
#pragma unroll
    for (int jj = 1; jj < 16; ++jj) s1j = (j == jj) ? sv[1][jj] : s1j;
    float cv[4];
#pragma unroll
    for (int q = 0; q < 4; ++q) { const float s0i = pick4(sv[0][4 * q], sv[0][4 * q + 1], sv[0][4 * q + 2], sv[0][4 * q + 3], ib);
        cv[q] = mkcand(s0i, s1j, (unsigned)(((4 * q + ib) << 4) | j)); }
    unsigned long long K0lo = 0ull, K0hi = 0ull, K1lo = 0ull, K1hi = 0ull;
#pragma unroll
    for (int i = 0; i < 8; ++i) {
        K0lo |= (unsigned long long)(__builtin_bit_cast(unsigned, sv[0][i]) & 127u) << (8 * i); K0hi |= (unsigned long long)(__builtin_bit_cast(unsigned, sv[0][8 + i]) & 127u) << (8 * i);
        K1lo |= (unsigned long long)(__builtin_bit_cast(unsigned, sv[1][i]) & 127u) << (8 * i); K1hi |= (unsigned long long)(__builtin_bit_cast(unsigned, sv[1][8 + i]) & 127u) << (8 * i); }
    float sel[16];
#pragma unroll
    for (int t = 0; t < 16; ++t) { const float m = wave_max(fmaxf(fmaxf(cv[0], cv[1]), fmaxf(cv[2], cv[3]))); sel[t] = m; const unsigned mb = __builtin_bit_cast(unsigned, m);
#pragma unroll
        for (int q = 0; q < 4; ++q) cv[q] = (__builtin_bit_cast(unsigned, cv[q]) == mb) ? NEG : cv[q]; }
    float e[16], esum = 0.f; int eidx[16];
#pragma unroll
    for (int t = 0; t < 16; ++t) { e[t] = __expf(sel[t] - sel[0]); esum += e[t];
        const unsigned tag = __builtin_bit_cast(unsigned, sel[t]) & 0xFFu;
        eidx[t] = (int)(keylook(K0lo, K0hi, tag >> 4) * 128u + keylook(K1lo, K1hi, tag & 15u)); }
    const float inv = 1.0f / esum;
    if (lane == 0) { int* o = SI + (size_t)tok * 128 + head * 16; float* og = SG + (size_t)tok * 128 + head * 16;
#pragma unroll
        for (int t = 0; t < 16; ++t) { o[t] = eidx[t]; og[t] = e[t] * inv; } }
}

__device__ __forceinline__ void p6_token(const bf16* H2B, const float* rowss, const int* SI, const float* SG, const bf16* UB, const bf16* VB, const float* gf, float* OUT, int tok, int lane) {
    const v4u* hb = (const v4u*)(H2B + (size_t)tok * D);
    const v4u xa = hb[lane], xb = hb[64 + lane];
    const unsigned xw[8] = {xa.x, xa.y, xa.z, xa.w, xb.x, xb.y, xb.z, xb.w};
    const float rstd2 = rsqrtf(rowss[tok] * (1.0f / D) + EPS);
    const int id0 = SI[(size_t)tok * 128 + lane], id1 = SI[(size_t)tok * 128 + 64 + lane];
    const float g0 = SG[(size_t)tok * 128 + lane], g1 = SG[(size_t)tok * 128 + 64 + lane];
    float out[16];
#pragma unroll
    for (int i = 0; i < 16; ++i) out[i] = 0.f;
    for (int e0 = 0; e0 < 128; e0 += 8) {
        v4u ur[8][2], vr[8][2]; float gt[8];
#pragma unroll
        for (int k = 0; k < 8; ++k) { const int e = e0 + k;
            const int idx = __builtin_amdgcn_readlane((e0 < 64) ? id0 : id1, e & 63);
            gt[k] = __builtin_bit_cast(float, __builtin_amdgcn_readlane(__builtin_bit_cast(int, (e0 < 64) ? g0 : g1), e & 63));
            const v4u* up = (const v4u*)(UB + (size_t)idx * D); const v4u* vp = (const v4u*)(VB + (size_t)idx * D);
            ur[k][0] = up[lane]; ur[k][1] = up[64 + lane]; vr[k][0] = vp[lane]; vr[k][1] = vp[64 + lane]; }
#pragma unroll
        for (int k = 0; k < 8; ++k) {
            const unsigned uw[8] = {ur[k][0].x, ur[k][0].y, ur[k][0].z, ur[k][0].w, ur[k][1].x, ur[k][1].y, ur[k][1].z, ur[k][1].w};
            float d = 0.f;
#pragma unroll
            for (int j = 0; j < 8; ++j) d = __builtin_amdgcn_fdot2_f32_bf16(__builtin_bit_cast(bf16x2_t, uw[j]), __builtin_bit_cast(bf16x2_t, xw[j]), d, false);
            d = wave_sum(d);
            const float a = d * rstd2;
            const float w = gt[k] * 0.5f * a * (1.0f + erff(a * 0.70710678118654752f));
            const unsigned vw[8] = {vr[k][0].x, vr[k][0].y, vr[k][0].z, vr[k][0].w, vr[k][1].x, vr[k][1].y, vr[k][1].z, vr[k][1].w};
#pragma unroll
            for (int j = 0; j < 8; ++j) { out[2 * j] += w * bflo(vw[j]); out[2 * j + 1] += w * bfhi(vw[j]); }
        }
    }
    f32x4* op = (f32x4*)(OUT + (size_t)tok * D);
    const f32x4* gp = (const f32x4*)gf;
    f32x4 y[4]; const int fi[4] = {2 * lane, 2 * lane + 1, 128 + 2 * lane, 129 + 2 * lane};
    float ss = 0.f;
#pragma unroll
    for (int q = 0; q < 4; ++q) { const f32x4 hv = op[fi[q]]; y[q] = (f32x4){hv.x + out[4 * q], hv.y + out[4 * q + 1], hv.z + out[4 * q + 2], hv.w + out[4 * q + 3]};
        ss += (y[q].x * y[q].x + y[q].y * y[q].y) + (y[q].z * y[q].z + y[q].w * y[q].w); }
    ss = wave_sum(ss);
    const float rs = rsqrtf(ss * (1.0f / D) + EPS);
#pragma unroll
    for (int q = 0; q < 4; ++q) op[fi[q]] = y[q] * rs * gp[fi[q]];
}

struct Args { const float* in[15]; float* out; unsigned char* ws; int ph_lo, ph_hi; };
constexpr int NPHASE = 7;
#ifndef MK_N_LAUNCHES
#define MK_N_LAUNCHES 1
#endif

__global__ void __launch_bounds__(NWAVES * 64, 2) fwd_kernel(Args args) {
    extern __shared__ __attribute__((aligned(16))) unsigned char lds_raw[];
    LAS unsigned char* lds = (LAS unsigned char*)lds_raw;
    volatile LAS unsigned* MISC = (volatile LAS unsigned*)(lds + MISC_OFF);
    const int tid = threadIdx.x, lane = tid & 63, wave = __builtin_amdgcn_readfirstlane(tid >> 6);
    const int G = gridDim.x, blk = blockIdx.x;
    unsigned char* ws = args.ws;
    const float* x = args.in[0]; const float* meta = args.in[1]; const float* g1 = args.in[2]; const float* w_in = args.in[3];
    const float* conv_w = args.in[4]; const float* conv_b = args.in[5]; const float* pool_w = args.in[6]; const float* pool_scale = args.in[7];
    const float* w_out = args.in[8]; const float* g2 = args.in[9]; const float* w_q = args.in[10]; const float* keys = args.in[11];
    const float* pu = args.in[12]; const float* pv = args.in[13]; const float* gf = args.in[14];
    bf16* WinT = (bf16*)(ws + WS_WIN); bf16* WoutT = (bf16*)(ws + WS_WOUT); bf16* WqT = (bf16*)(ws + WS_WQ); bf16* KB = (bf16*)(ws + WS_KEYS);
    float* rstd1 = (float*)(ws + WS_RSTD1); float* rowss = (float*)(ws + WS_ROWSS);
    bf16* UB = (bf16*)(ws + WS_UB); bf16* VB = (bf16*)(ws + WS_VB); bf16* XB = (bf16*)(ws + WS_XB); bf16* YP = (bf16*)(ws + WS_XB);
    bf16* P = (bf16*)(ws + WS_P); bf16* Qb = (bf16*)(ws + WS_P); bf16* H2B = (bf16*)(ws + WS_H2B);
    int* SI = (int*)(ws + WS_SELI); float* SG = (float*)(ws + WS_SELG);

    for (int u = tid; u < (LDS_BYTES - RING_BYTES) / 4; u += NWAVES * 64) ((LAS unsigned*)(lds + RING_BYTES))[u] = 0u;
    __syncthreads();
    const int lo = args.ph_lo, hi = args.ph_hi;
    XcdBarrier bar; bar.bar = (unsigned*)(ws + WS_CTL) + CW_BAR; bar.x = 0; bar.st = nullptr;
    if (hi - lo > 1) bar = xcd_barrier_post((unsigned*)(ws + WS_CTL) + CW_BAR, MISC + 8);
#define IN(k) (lo <= (k) && (k) < hi)
#define SEAM(k) do { if (IN(k) && IN((k) + 1)) xcd_barrier(bar); } while (0)
    const int gw = blk * NWAVES + wave, NGW = G * NWAVES;

    if (IN(0)) {
        for (int mb = blk; mb < 256; mb += G) p0_meta(meta, g1, w_in, P, lds, mb, tid);
        LAS float* scr = (LAS float*)(lds + wave * 16384);
        for (int it = gw; it < 1024 + 1024 + 256 + 1024; it += NGW) {
            int r = __builtin_amdgcn_readfirstlane(it);
            if (r < 1024) { p0_transpose_item(w_in, D, NP, g1, WinT, scr, r, lane); continue; } r -= 1024;
            if (r < 1024) { p0_transpose_item(w_q, D, NQ, g2, WqT, scr, r, lane); continue; } r -= 1024;
            if (r < 256) { p0_transpose_item(w_out, D, D, nullptr, WoutT, scr, r, lane); continue; } r -= 256;
            p0_weff_item(w_out, pool_w, pool_scale, WoutT, r, lane);
        }
        for (int m = gw; m < T; m += NGW) row_to_bf16(x + (size_t)m * D, XB + (size_t)m * D, nullptr, rstd1 + m, lane);
        for (int m = gw; m < NEXP; m += NGW) { row_to_bf16(pu + (size_t)m * D, UB + (size_t)m * D, g2, nullptr, lane); row_to_bf16(pv + (size_t)m * D, VB + (size_t)m * D, nullptr, nullptr, lane); }
        for (int m = gw; m < 256; m += NGW) row_to_bf16(keys + (size_t)m * D, KB + (size_t)m * D, nullptr, nullptr, lane);
    }
    SEAM(0);
    if (IN(1)) {
        pg8::Gemm g{XB, WinT, T, NP, D}; pg8::StaticOrder S; S.init(T, NP, G, blk);
        EpiP E{P, rstd1};
        pg8::gemm_phase<EpiP, pg8::StaticOrder, true, true>(lds, g, S, E);
    }
    SEAM(1);
    if (IN(2)) {
        for (int b2 = blk; b2 < T / 128; b2 += G) p2_convpool(P, conv_w, conv_b, YP, b2, tid);
    }
    SEAM(2);
    if (IN(3)) {
        pg8::Gemm g{YP, WoutT, T, D, D}; pg8::StaticOrder S; S.init(T, D, G, blk);
        EpiH2 E{x, args.out, H2B, rowss};
        pg8::gemm_phase<EpiH2, pg8::StaticOrder, true, true>(lds, g, S, E);
    }
    SEAM(3);
    if (IN(4)) {
        pg8::Gemm g{H2B, WqT, T, NQ, D}; pg8::StaticOrder S; S.init(T, NQ, G, blk);
        EpiQ E{Qb, rowss};
        pg8::gemm_phase<EpiQ, pg8::StaticOrder, true, true>(lds, g, S, E);
    }
    SEAM(4);
    if (IN(5)) {
#ifdef P5_SIMPLE
        for (int it = gw; it < T * 8; it += NGW) p5_simple(Qb, KB, SI, SG, it >> 3, it & 7, lane);
#else
        for (int it = gw; it < (T / 32) * 8; it += NGW) p5_item(Qb, KB, SI, SG, it >> 3, it & 7, lane);
#endif
    }
    SEAM(5);
    if (IN(6)) {
        for (int tok = gw; tok < T; tok += NGW) p6_token(H2B, rowss, SI, SG, UB, VB, gf, args.out, tok, lane);
    }
#undef IN
#undef SEAM
}

extern "C" void kernel_launch(void* const* d_in, const int* in_sizes, int n_in, void* d_out, int out_size, void* d_ws, size_t ws_size, hipStream_t stream) {
    static int grid = 0;
    if (grid == 0) {
        if (n_in != 15 || out_size != T * D || ws_size < WS_END) { fprintf(stderr, "kernel_launch: unexpected shapes: n_in %d out %d ws %zu (need %zu)\n", n_in, out_size, ws_size, (size_t)WS_END); grid = -1; return; }
        int dev = 0, cus = 0, per_cu = 0;
        if (hipGetDevice(&dev) != hipSuccess || hipDeviceGetAttribute(&cus, hipDeviceAttributeMultiprocessorCount, dev) != hipSuccess) { grid = -1; return; }
        if (hipFuncSetAttribute((const void*)fwd_kernel, hipFuncAttributeMaxDynamicSharedMemorySize, LDS_BYTES) != hipSuccess) { fprintf(stderr, "kernel_launch: hipFuncSetAttribute failed\n"); grid = -1; return; }
        if (hipOccupancyMaxActiveBlocksPerMultiprocessor(&per_cu, (const void*)fwd_kernel, NWAVES * 64, LDS_BYTES) != hipSuccess || per_cu < 1) fprintf(stderr, "kernel_launch: occupancy query says %d\n", per_cu);
        (void)hipGetLastError();
        grid = cus;
    }
    if (grid < 0) return;
    (void)hipMemsetAsync((char*)d_ws + WS_CTL, 0, CTL_ZERO_BYTES, stream);
    Args a{};
    for (int i = 0; i < 15; ++i) a.in[i] = (const float*)d_in[i];
    a.out = (float*)d_out; a.ws = (unsigned char*)d_ws;
#if MK_N_LAUNCHES == 1
    a.ph_lo = 0; a.ph_hi = NPHASE;
    hipLaunchKernelGGL(fwd_kernel, dim3(grid), dim3(NWAVES * 64), LDS_BYTES, stream, a);
#else
    for (int li = 0; li < NPHASE; ++li) { a.ph_lo = li; a.ph_hi = li + 1;
        hipLaunchKernelGGL(fwd_kernel, dim3(grid), dim3(NWAVES * 64), LDS_BYTES, stream, a); }
#endif
}
```

```cpp
#include <hip/hip_runtime.h>
#include <cstdio>
#include <cstdint>
namespace pg8 {
#define PG8_LAS __attribute__((address_space(3)))
typedef unsigned short bf16_t;
typedef short bf16x8 __attribute__((ext_vector_type(8)));
typedef float f32x4 __attribute__((ext_vector_type(4)));
typedef unsigned u32x4 __attribute__((ext_vector_type(4)));
constexpr int BM = 256, BK = 64, HALF = 128, HTB = HALF * BK * 2  , STAGE_BYTES = 8 * HTB, NXCD = 8, WGM = 8;

__host__ __device__ __forceinline__ int lds_byte(int r, int c) { const int st = (r >> 4) * 2 + (c >> 5), rr = r & 15, cc = c & 31, ob = rr * 64 + cc * 2; return st * 1024 + (ob ^ (((ob >> 9) & 1) << 5)); }
__host__ __device__ __forceinline__ void stage_rc(int b, int& R, int& C) { const int st = b / 1024, sb = b % 1024, swz = sb ^ (((sb >> 9) & 1) << 5); R = (st >> 1) * 16 + swz / 64; C = (st & 1) * 32 + (swz % 64) / 2; }
__host__ __device__ __forceinline__ int perm32(int rho) { const int n = rho >> 4, i = rho & 15; return 8 * (i >> 2) + 4 * n + (i & 3); }

struct Unit { int pm, pn; };
struct Gemm { const bf16_t* A; const bf16_t* Bt; int M, N, K; };

struct StaticOrder {
    int nM, nN, nwg, G, c;
    __host__ __device__ void init(int M, int N, int G_, int c_) { nM = M / BM; nN = N / BM; nwg = nM * nN; G = G_; c = c_; }
    __host__ __device__ bool next(int i, Unit& u) const {
        const long L = (long)i * G + c; if (L >= nwg) return false;
        int wgid = (int)L; { const int q = nwg / NXCD, r = nwg % NXCD, xcd = wgid % NXCD, off = wgid / NXCD; wgid = (xcd < r ? xcd * (q + 1) : r * (q + 1) + (xcd - r) * q) + off; }
        const int nig = WGM * nN, gid = wgid / nig, fm = gid * WGM, gsz = (nM - fm) < WGM ? (nM - fm) : WGM;
        u.pm = fm + ((wgid % nig) % gsz); u.pn = (wgid % nig) / gsz; return true;
    }
    __device__ __forceinline__ void a_ready(const Unit&) const {}
    __device__ __forceinline__ void done(const Unit&) const {}
};

__device__ __forceinline__ unsigned cvt_pk_bf16(float lo, float hi) { unsigned r; asm volatile("v_cvt_pk_bf16_f32 %0, %1, %2" : "=v"(r) : "v"(lo), "v"(hi)); return r; }
template <class Epi, class Sched, bool ALIGN_EPI = false, bool SP2 = false>
__device__ __forceinline__ void gemm_phase(PG8_LAS unsigned char* lds, const Gemm g, const Sched& S, const Epi& E) {
    const int tid = threadIdx.x, wid = __builtin_amdgcn_readfirstlane(tid >> 6), lane = tid & 63, wr = wid >> 2, wc = wid & 3, fr = lane & 15, fq = lane >> 4;
    const int K = g.K, nt = K / BK;
    unsigned voffA[2], voffB[2];
#pragma unroll
    for (int i = 0; i < 2; ++i) { int R, C; stage_rc(tid * 16 + i * 8192, R, C); const int Rb = Epi::PERM ? ((R & ~31) + perm32(R & 31)) : R;
        voffA[i] = (unsigned)(R * K + C) * 2u; voffB[i] = (unsigned)(Rb * K + C) * 2u; }
    const size_t kstep = (size_t)(BK * 2);
    const size_t hstep = (size_t)HALF * K * 2;
    const size_t tstep = 2 * hstep;
    const unsigned ldsw = (unsigned)wid * 1024u;
    const int aoff = lds_byte(wr * 64 + fr, fq * 8), boff = lds_byte(wc * 32 + fr, fq * 8);
#define PG8_SA(b, h) (((b) * 2 + (h)) * HTB)
#define PG8_SB(b, h) ((4 + (b) * 2 + (h)) * HTB)
#define PG8_STAGE(bufoff, gbase, voff) do { _Pragma("unroll") for (int _i = 0; _i < 2; ++_i) \
        __builtin_amdgcn_global_load_lds((const unsigned*)((const char*)(gbase) + (voff)[_i]), (PG8_LAS unsigned*)(lds + (bufoff) + ldsw + _i * 8192), 16, 0, 0); } while (0)
#define PG8_LDA(dst, b, h) do { _Pragma("unroll") for (int m = 0; m < 4; ++m) _Pragma("unroll") for (int k = 0; k < 2; ++k) dst[m][k] = *(const PG8_LAS bf16x8*)(lds + PG8_SA(b, h) + aoff + m * 2048 + k * 1024); } while (0)
#define PG8_LDB(dst, b, h) do { _Pragma("unroll") for (int n = 0; n < 2; ++n) _Pragma("unroll") for (int k = 0; k < 2; ++k) dst[n][k] = *(const PG8_LAS bf16x8*)(lds + PG8_SB(b, h) + boff + n * 2048 + k * 1024); } while (0)
#define PG8_MMA(ai, bj, At, Bt) do { __builtin_amdgcn_s_setprio(1); _Pragma("unroll") for (int m = 0; m < 4; ++m) _Pragma("unroll") for (int n = 0; n < 2; ++n) _Pragma("unroll") for (int k = 0; k < 2; ++k) \
        acc[ai][bj][m][n] = __builtin_amdgcn_mfma_f32_16x16x32_bf16(Bt[n][k], At[m][k], acc[ai][bj][m][n], 0, 0, 0); __builtin_amdgcn_s_setprio(0); } while (0)
#define PG8_WAIT_V(n) asm volatile("s_waitcnt vmcnt(" #n ")" ::: "memory")
#define PG8_WAIT_L(n) asm volatile("s_waitcnt lgkmcnt(" #n ")" ::: "memory")
#define PG8_BAR __builtin_amdgcn_s_barrier()
#define PG8_SCHED __builtin_amdgcn_sched_barrier(0)
    Unit cur, nxt; int ui = 0;
    if (!S.next(0, cur)) return;
    f32x4 acc[2][2][4][2];
#pragma unroll
    for (int a = 0; a < 2; ++a)
#pragma unroll
        for (int b = 0; b < 2; ++b)
#pragma unroll
            for (int m = 0; m < 4; ++m)
#pragma unroll
                for (int n = 0; n < 2; ++n) acc[a][b][m][n] = (f32x4){0.f, 0.f, 0.f, 0.f};
    bf16x8 At[4][2], B0[2][2], B1[2][2];
    const char* cA = (const char*)g.A + (size_t)cur.pm * tstep; const char* cB = (const char*)g.Bt + (size_t)cur.pn * tstep;
    S.a_ready(cur);
    if constexpr (SP2) {
        PG8_STAGE(PG8_SB(0, 0), cB, voffB); PG8_STAGE(PG8_SB(0, 1), cB + hstep, voffB); PG8_STAGE(PG8_SA(0, 0), cA, voffA); PG8_STAGE(PG8_SA(0, 1), cA + hstep, voffA);
        if (wr == 1) PG8_BAR;
        PG8_WAIT_V(2); PG8_BAR;
        PG8_STAGE(PG8_SB(1, 0), cB + kstep, voffB); PG8_STAGE(PG8_SA(1, 0), cA + kstep, voffA); PG8_STAGE(PG8_SB(1, 1), cB + hstep + kstep, voffB);
        PG8_WAIT_V(6); PG8_BAR;
    } else {
        PG8_STAGE(PG8_SB(0, 0), cB, voffB); PG8_STAGE(PG8_SA(0, 0), cA, voffA); PG8_STAGE(PG8_SB(0, 1), cB + hstep, voffB); PG8_STAGE(PG8_SA(0, 1), cA + hstep, voffA);
        if (wr == 1) PG8_BAR;
        PG8_WAIT_V(4); PG8_BAR;
        PG8_STAGE(PG8_SB(1, 0), cB + kstep, voffB); PG8_STAGE(PG8_SA(1, 0), cA + kstep, voffA); PG8_STAGE(PG8_SB(1, 1), cB + hstep + kstep, voffB);
        PG8_WAIT_V(6); PG8_BAR;
    }
    for (;;) {
        const bool has_next = S.next(ui + 1, nxt);
        const char* nA = has_next ? (const char*)g.A + (size_t)nxt.pm * tstep : cA; const char* nB = has_next ? (const char*)g.Bt + (size_t)nxt.pn * tstep : cB;
        for (int t = 0; t < nt; t += 2) {
            const bool last = (t == nt - 2);
            const char* a1 = cA + (size_t)(t + 1) * kstep;
            const char* a2 = last ? nA : cA + (size_t)(t + 2) * kstep; const char* b2 = last ? nB : cB + (size_t)(t + 2) * kstep;
            const char* a3 = a2 + kstep; const char* b3 = b2 + kstep;
            if (last && has_next) S.a_ready(nxt);
            if constexpr (SP2) {
            PG8_LDB(B0, 0, 0); PG8_LDB(B1, 0, 1); PG8_SCHED; PG8_LDA(At, 0, 0); PG8_STAGE(PG8_SA(1, 1), a1 + hstep, voffA);
            PG8_WAIT_V(8); PG8_WAIT_L(0); PG8_BAR; PG8_MMA(0, 0, At, B0); PG8_MMA(0, 1, At, B1); PG8_BAR; PG8_SCHED;
            PG8_LDA(At, 0, 1); PG8_STAGE(PG8_SB(0, 0), b2, voffB); PG8_STAGE(PG8_SB(0, 1), b2 + hstep, voffB); PG8_STAGE(PG8_SA(0, 0), a2, voffA);
            PG8_WAIT_V(8); PG8_WAIT_L(0); PG8_BAR; PG8_MMA(1, 0, At, B0); PG8_MMA(1, 1, At, B1); PG8_BAR; PG8_SCHED;
            PG8_LDB(B0, 1, 0); PG8_LDB(B1, 1, 1); PG8_SCHED; PG8_LDA(At, 1, 0); PG8_STAGE(PG8_SA(0, 1), a2 + hstep, voffA);
            PG8_WAIT_V(8); PG8_WAIT_L(0); PG8_BAR; PG8_MMA(0, 0, At, B0); PG8_MMA(0, 1, At, B1); PG8_BAR; PG8_SCHED;
            PG8_LDA(At, 1, 1); PG8_STAGE(PG8_SB(1, 0), b3, voffB); PG8_STAGE(PG8_SB(1, 1), b3 + hstep, voffB); PG8_STAGE(PG8_SA(1, 0), a3, voffA);
            PG8_WAIT_V(8); PG8_WAIT_L(0); PG8_BAR; PG8_MMA(1, 0, At, B0); PG8_MMA(1, 1, At, B1); PG8_BAR; PG8_SCHED;
            } else {
            PG8_LDB(B0, 0, 0); PG8_SCHED; PG8_LDA(At, 0, 0); PG8_STAGE(PG8_SA(1, 1), a1 + hstep, voffA);
            PG8_WAIT_L(8); PG8_BAR; PG8_WAIT_L(0); PG8_MMA(0, 0, At, B0); PG8_BAR; PG8_SCHED;
            PG8_LDB(B1, 0, 1); PG8_STAGE(PG8_SB(0, 0), b2, voffB);
            PG8_BAR; PG8_WAIT_L(0); PG8_MMA(0, 1, At, B1); PG8_BAR;
            PG8_LDA(At, 0, 1); PG8_STAGE(PG8_SA(0, 0), a2, voffA);
            PG8_BAR; PG8_WAIT_L(0); PG8_MMA(1, 0, At, B0); PG8_BAR; PG8_SCHED;
            PG8_STAGE(PG8_SB(0, 1), b2 + hstep, voffB);
            PG8_WAIT_V(6); PG8_BAR; PG8_MMA(1, 1, At, B1); PG8_BAR;
            PG8_LDB(B0, 1, 0); PG8_SCHED; PG8_LDA(At, 1, 0); PG8_STAGE(PG8_SA(0, 1), a2 + hstep, voffA);
            PG8_WAIT_L(8); PG8_BAR; PG8_WAIT_L(0); PG8_MMA(0, 0, At, B0); PG8_BAR; PG8_SCHED;
            PG8_LDB(B1, 1, 1); PG8_STAGE(PG8_SB(1, 0), b3, voffB);
            PG8_BAR; PG8_WAIT_L(0); PG8_MMA(0, 1, At, B1); PG8_BAR;
            PG8_LDA(At, 1, 1); PG8_STAGE(PG8_SA(1, 0), a3, voffA);
            PG8_BAR; PG8_WAIT_L(0); PG8_MMA(1, 0, At, B0); PG8_BAR; PG8_SCHED;
            PG8_STAGE(PG8_SB(1, 1), b3 + hstep, voffB);
            PG8_WAIT_V(6); PG8_BAR; PG8_MMA(1, 1, At, B1); PG8_BAR;
            }
        }
        if constexpr (ALIGN_EPI) { if (wr == 0) PG8_BAR; }
        if constexpr (!Epi::AFTER_DRAIN) { E(acc, cur, wr, wc, fr, fq); S.done(cur); }
        if (!has_next) break;
#pragma unroll
        for (int a = 0; a < 2; ++a)
#pragma unroll
            for (int b = 0; b < 2; ++b)
#pragma unroll
                for (int m = 0; m < 4; ++m)
#pragma unroll
                    for (int n = 0; n < 2; ++n) acc[a][b][m][n] = (f32x4){0.f, 0.f, 0.f, 0.f};
        cur = nxt; cA = nA; cB = nB; ++ui;
        if constexpr (ALIGN_EPI) { if (wr == 1) PG8_BAR; }
    }
    PG8_WAIT_V(0);
    if constexpr (!ALIGN_EPI) { if (wr == 0) PG8_BAR; }
    PG8_BAR;
    if constexpr (Epi::AFTER_DRAIN) { E.fused(acc, cur, wr, wc, fr, fq, lds, wid, lane); S.done(cur); }
#undef PG8_SA
#undef PG8_SB
#undef PG8_STAGE
#undef PG8_LDA
#undef PG8_LDB
#undef PG8_MMA
#undef PG8_WAIT_V
#undef PG8_WAIT_L
#undef PG8_BAR
#undef PG8_SCHED
}
}

#define GAS __attribute__((address_space(1)))
#define LAS __attribute__((address_space(3)))
#define XB_TMO      128
#define XB_XCNT(j)  (256  + 64 * (j))
#define XB_XSUB(j)  (1280 + 64 * (j))
#define XB_XGEN(j)  (2304 + 64 * (j))
#define XB_TOP      3328
#define XB_TOPGEN   3392
#define XCD_BAR_WORDS 3456
#define XB_SPIN_CAP (1u << 18)

__device__ __forceinline__ unsigned xb_ld(unsigned* p)              { return __hip_atomic_load(p, __ATOMIC_RELAXED, __HIP_MEMORY_SCOPE_AGENT); }
__device__ __forceinline__ unsigned xb_add(unsigned* p, unsigned v) { return __hip_atomic_fetch_add(p, v, __ATOMIC_RELAXED, __HIP_MEMORY_SCOPE_AGENT); }
__device__ __forceinline__ unsigned xb_xcc_id() { return (unsigned)__builtin_amdgcn_s_getreg((3 << 11) | 20) & 0xFu; }
#define XB_SPIN(cond, bar) do { unsigned _sp = 0; while (cond) { __builtin_amdgcn_s_sleep(1); \
    if ((++_sp & 255u) == 0u) { if (xb_ld(&(bar)[XB_TMO])) break; if (_sp > XB_SPIN_CAP) { atomicAdd(&(bar)[XB_TMO], 1u); break; } } } } while (0)

struct XcdBarrier {
    unsigned* bar; unsigned x;
    volatile LAS unsigned* st;
};

__device__ __forceinline__ XcdBarrier xcd_barrier_post(unsigned* bar, volatile LAS unsigned* st) {
    XcdBarrier b; b.bar = bar; b.x = xb_xcc_id(); b.st = st;
    if (threadIdx.x == 0) (void)xb_add(&bar[XB_XCNT(b.x)], 1u);
    return b;
}
__device__ __forceinline__ void xcd_barrier_complete(unsigned* bar, unsigned x, unsigned& nloc, unsigned& nx) {
    const unsigned G = gridDim.x * gridDim.y * gridDim.z;
    unsigned sum, cnt, mine, sp = 0u;
    for (;;) {
        sum = 0u; cnt = 0u; mine = 0u;
#pragma unroll
        for (unsigned j = 0; j < 16; ++j) { const unsigned c = xb_ld(&bar[XB_XCNT(j)]); sum += c; cnt += (c > 0u) ? 1u : 0u; mine = (j == x) ? c : mine; }
        if (sum == G) break;
        __builtin_amdgcn_s_sleep(1);
        if ((++sp & 255u) == 0u) { if (xb_ld(&bar[XB_TMO])) break; if (sp > XB_SPIN_CAP) { atomicAdd(&bar[XB_TMO], 1u); break; } }
    }
    nloc = mine > 0u ? mine : 1u; nx = cnt > 0u ? cnt : 1u;
}

__device__ __forceinline__ void xcd_barrier(const XcdBarrier& b) {
    asm volatile("s_waitcnt vmcnt(0)" ::: "memory");
    __syncthreads();
    if (threadIdx.x == 0) {
        unsigned* bar = b.bar;
        __builtin_amdgcn_s_waitcnt(0);
        unsigned nloc = b.st[0], nx = b.st[1];
        if (nloc == 0u) { xcd_barrier_complete(bar, b.x, nloc, nx); b.st[0] = nloc; b.st[1] = nx; }
        const unsigned old = xb_add(&bar[XB_XSUB(b.x)], 1u);
        const unsigned gen = old / nloc;
        if (old + 1u == (gen + 1u) * nloc) {
            __builtin_amdgcn_fence(__ATOMIC_RELEASE, "agent");
            asm volatile("s_waitcnt vmcnt(0)" ::: "memory");
            const unsigned og = xb_add(&bar[XB_TOP], 1u);
            const unsigned tg = og / nx;
            if (og + 1u == (tg + 1u) * nx) xb_add(&bar[XB_TOPGEN], 1u);
            else XB_SPIN(xb_ld(&bar[XB_TOPGEN]) == tg, bar);
            __builtin_amdgcn_fence(__ATOMIC_ACQUIRE, "agent");
            xb_add(&bar[XB_XGEN(b.x)], 1u);
            asm volatile("s_waitcnt vmcnt(0)" ::: "memory");
        } else {
            XB_SPIN(xb_ld(&bar[XB_XGEN(b.x)]) == gen, bar);
            __builtin_amdgcn_fence(__ATOMIC_ACQUIRE, "agent");
            asm volatile("s_waitcnt vmcnt(0)" ::: "memory");
        }
    }
    __syncthreads();
}

constexpr int D = 1024, BATCH = 4, SEQ = 8192, NMETA = 16, LSEQ = SEQ + NMETA;
constexpr int T = BATCH * SEQ;
constexpr int NP = 2048, NQ = 2048, NEXP = 16384;
constexpr float EPS = 1e-6f;
constexpr int NWAVES = 8;

constexpr size_t MiB = 1u << 20;
constexpr size_t WS_CTL = 0, CTL_ZERO_BYTES = 1 * MiB;
constexpr int CW_BAR = 4096;
constexpr size_t WS_ROWSS = 512 * 1024;
constexpr size_t WS_WIN = 2 * MiB, WS_WOUT = 6 * MiB, WS_WQ = 8 * MiB, WS_KEYS = 12 * MiB, WS_RSTD1 = 13 * MiB;
constexpr size_t WS_UB = 16 * MiB  , WS_VB = 48 * MiB  , WS_XB = 80 * MiB  , WS_P = 144 * MiB  ;
constexpr size_t WS_H2B = 274 * MiB, WS_SELI = 338 * MiB, WS_SELG = 354 * MiB, WS_END = 370 * MiB;

constexpr int RING_BYTES = 131072, MISC_OFF = RING_BYTES + 320, LDS_BYTES = 147456;

typedef unsigned short bf16;
typedef unsigned v4u __attribute__((ext_vector_type(4)));
typedef unsigned v2u __attribute__((ext_vector_type(2)));
typedef float f32x4 __attribute__((ext_vector_type(4)));
typedef float f32x16 __attribute__((ext_vector_type(16)));
typedef short bf16x8 __attribute__((ext_vector_type(8)));
typedef __bf16 bf16x2_t __attribute__((ext_vector_type(2)));
#define LDS_WAIT() asm volatile("s_waitcnt lgkmcnt(0)" ::: "memory")

__device__ __forceinline__ unsigned f2bf(float f) { unsigned u = __builtin_bit_cast(unsigned, f); return (u + 0x7fffu + ((u >> 16) & 1u)) >> 16; }
__device__ __forceinline__ unsigned pk2(float lo, float hi) { return f2bf(lo) | (f2bf(hi) << 16); }
__device__ __forceinline__ float bflo(unsigned w) { return __builtin_bit_cast(float, w << 16); }
__device__ __forceinline__ float bfhi(unsigned w) { return __builtin_bit_cast(float, w & 0xffff0000u); }
__device__ __forceinline__ float wave_sum(float v) {
#pragma unroll
    for (int o = 1; o < 64; o <<= 1) v += __shfl_xor(v, o);
    return v;
}

struct EpiP {
    static constexpr bool PERM = true, AFTER_DRAIN = false;
    bf16* P; const float* rstd;
    __device__ __forceinline__ void operator()(const pg8::f32x4 (&acc)[2][2][4][2], const pg8::Unit& u, int wr, int wc, int fr, int fq) const {
        const int row0 = u.pm * 256 + wr * 64 + fr, col0 = u.pn * 256 + wc * 32 + 8 * fq;
#pragma unroll
        for (int ai = 0; ai < 2; ++ai)
#pragma unroll
            for (int m = 0; m < 4; ++m) {
                const int row = row0 + ai * 128 + m * 16; const float rs = rstd[row];
                bf16* rowp = P + ((size_t)(row >> 13) * LSEQ + NMETA + (row & 8191)) * NP + col0;
#pragma unroll
                for (int bj = 0; bj < 2; ++bj) { const pg8::f32x4 v0 = acc[ai][bj][m][0] * rs, v1 = acc[ai][bj][m][1] * rs;
                    v4u w; w.x = pg8::cvt_pk_bf16(v0[0], v0[1]); w.y = pg8::cvt_pk_bf16(v0[2], v0[3]); w.z = pg8::cvt_pk_bf16(v1[0], v1[1]); w.w = pg8::cvt_pk_bf16(v1[2], v1[3]);
                    *(v4u*)(rowp + bj * 128) = w; }
            }
    }
};
struct EpiH2 {
    static constexpr bool PERM = true, AFTER_DRAIN = false;
    const float* X; float* H2; bf16* H2B; float* rowss;
    __device__ __forceinline__ void operator()(const pg8::f32x4 (&acc)[2][2][4][2], const pg8::Unit& u, int wr, int wc, int fr, int fq) const {
        const int row0 = u.pm * 256 + wr * 64 + fr, col0 = u.pn * 256 + wc * 32 + 8 * fq;
#pragma unroll
        for (int ai = 0; ai < 2; ++ai)
#pragma unroll
            for (int m = 0; m < 4; ++m) {
                const int row = row0 + ai * 128 + m * 16; const size_t off = (size_t)row * D + col0; float ss = 0.f;
#pragma unroll
                for (int bj = 0; bj < 2; ++bj) {
                    const pg8::f32x4 x0 = *(const pg8::f32x4*)(X + off + bj * 128), x1 = *(const pg8::f32x4*)(X + off + bj * 128 + 4);
                    const pg8::f32x4 v0 = acc[ai][bj][m][0] + x0, v1 = acc[ai][bj][m][1] + x1;
                    *(pg8::f32x4*)(H2 + off + bj * 128) = v0; *(pg8::f32x4*)(H2 + off + bj * 128 + 4) = v1;
                    v4u w; w.x = pg8::cvt_pk_bf16(v0[0], v0[1]); w.y = pg8::cvt_pk_bf16(v0[2], v0[3]); w.z = pg8::cvt_pk_bf16(v1[0], v1[1]); w.w = pg8::cvt_pk_bf16(v1[2], v1[3]);
                    *(v4u*)(H2B + off + bj * 128) = w;
                    ss += (v0[0] * v0[0] + v0[1] * v0[1]) + (v0[2] * v0[2] + v0[3] * v0[3]) + (v1[0] * v1[0] + v1[1] * v1[1]) + (v1[2] * v1[2] + v1[3] * v1[3]);
                }
                ss += __shfl_xor(ss, 16); ss += __shfl_xor(ss, 32);
                if (fq == 0) atomicAdd(rowss + row, ss);
            }
    }
};
struct EpiQ {
    static constexpr bool PERM = true, AFTER_DRAIN = false;
    bf16* Q; const float* rowss;
    __device__ __forceinline__ void operator()(const pg8::f32x4 (&acc)[2][2][4][2], const pg8::Unit& u, int wr, int wc, int fr, int fq) const {
        const int row0 = u.pm * 256 + wr * 64 + fr, col0 = u.pn * 256 + wc * 32 + 8 * fq;
#pragma unroll
        for (int ai = 0; ai < 2; ++ai)
#pragma unroll
            for (int m = 0; m < 4; ++m) {
                const int row = row0 + ai * 128 + m * 16; const float rs = rsqrtf(rowss[row] * (1.0f / D) + EPS);
                bf16* rowp = Q + (size_t)row * NQ + col0;
#pragma unroll
                for (int bj = 0; bj < 2; ++bj) { const pg8::f32x4 v0 = acc[ai][bj][m][0] * rs, v1 = acc[ai][bj][m][1] * rs;
                    v4u w; w.x = pg8::cvt_pk_bf16(v0[0], v0[1]); w.y = pg8::cvt_pk_bf16(v0[2], v0[3]); w.z = pg8::cvt_pk_bf16(v1[0], v1[1]); w.w = pg8::cvt_pk_bf16(v1[2], v1[3]);
                    *(v4u*)(rowp + bj * 128) = w; }
            }
    }
};

__device__ __forceinline__ void row_to_bf16(const float* src, bf16* dst, const float* gain, float* rstd_out, int lane) {
    const f32x4* xr = (const f32x4*)src + lane;
    f32x4 v[4]; float s = 0.f;
#pragma unroll
    for (int j = 0; j < 4; ++j) { v[j] = xr[64 * j]; s += (v[j].x * v[j].x + v[j].y * v[j].y) + (v[j].z * v[j].z + v[j].w * v[j].w); }
    if (rstd_out) { s = wave_sum(s); if (lane == 0) *rstd_out = rsqrtf(s * (1.0f / D) + EPS); }
    if (gain) {
#pragma unroll
        for (int j = 0; j < 4; ++j) v[j] = v[j] * ((const f32x4*)gain)[lane + 64 * j];
    }
    unsigned long long* o8 = (unsigned long long*)dst + lane;
#pragma unroll
    for (int j = 0; j < 4; ++j) o8[64 * j] = (unsigned long long)pk2(v[j].x, v[j].y) | ((unsigned long long)pk2(v[j].z, v[j].w) << 32);
}
typedef float f32x2 __attribute__((ext_vector_type(2)));
constexpr float U8_SCALE = 64.0f, V8_SCALE = 8.0f;
__device__ __forceinline__ void row_to_fp8(const float* src, unsigned char* dst, const float* gain, float scale, int lane) {
    const f32x4* xr = (const f32x4*)src + lane;
    unsigned* o = (unsigned*)dst + lane;
#pragma unroll
    for (int j = 0; j < 4; ++j) { f32x4 v = xr[64 * j]; if (gain) v = v * ((const f32x4*)gain)[lane + 64 * j]; v = v * scale;
        int pk = 0; pk = __builtin_amdgcn_cvt_pk_fp8_f32(v.x, v.y, pk, false); pk = __builtin_amdgcn_cvt_pk_fp8_f32(v.z, v.w, pk, true);
        o[64 * j] = (unsigned)pk; }
}
__device__ __forceinline__ void p0_transpose_item(const float* W, int K, int N, const float* gain, bf16* WT, LAS float* scr, int item, int lane) {
    const int nblk = N / 32, kb = item / nblk, nb = item % nblk, k0 = 64 * kb, n0 = 32 * nb;
#pragma unroll 8
    for (int i = 0; i < 32; ++i) { const int kk = 2 * i + (lane >> 5); const float gk = gain ? gain[k0 + kk] : 1.0f; scr[kk * 33 + (lane & 31)] = W[(size_t)(k0 + kk) * N + n0 + (lane & 31)] * gk; }
    LDS_WAIT(); asm volatile("" ::: "memory");
    const int c = lane & 7;
#pragma unroll
    for (int j = 0; j < 4; ++j) { const int n = (lane >> 3) + 8 * j; const LAS float* s = scr + (8 * c) * 33 + n;
        v4u o; o.x = pk2(s[0 * 33], s[1 * 33]); o.y = pk2(s[2 * 33], s[3 * 33]); o.z = pk2(s[4 * 33], s[5 * 33]); o.w = pk2(s[6 * 33], s[7 * 33]);
        *(v4u*)(WT + (size_t)(n0 + n) * K + k0 + 8 * c) = o; }
    LDS_WAIT(); asm volatile("" ::: "memory");
}
__device__ __forceinline__ void p0_weff_item(const float* w_out, const float* pool_w, const float* pool_scale, bf16* WoutT, int item, int lane) {
    const int nb = item & 15, cg = (item >> 4) & 15, g = item >> 8;
    const int n = nb * 64 + lane;
    float acc[8];
#pragma unroll
    for (int i = 0; i < 8; ++i) acc[i] = 0.f;
    const float* wo = w_out + (size_t)(512 + g * 128) * D + n;
    const float* pw = pool_w + (size_t)(g * 128 + cg * 8) * 128;
    const float* ps = pool_scale + g * 128;
#pragma unroll 4
    for (int d = 0; d < 128; ++d) { const float w = wo[(size_t)d * D] * ps[d];
#pragma unroll
        for (int i = 0; i < 8; ++i) acc[i] += pw[i * 128 + d] * w; }
    v4u o; o.x = pk2(acc[0], acc[1]); o.y = pk2(acc[2], acc[3]); o.z = pk2(acc[4], acc[5]); o.w = pk2(acc[6], acc[7]);
    *(v4u*)(WoutT + (size_t)n * D + 512 + g * 128 + cg * 8) = o;
}
__device__ __forceinline__ void p0_meta(const float* meta, const float* g1, const float* w_in, bf16* P, LAS unsigned char* lds, int blk, int tid) {
    LAS float* mg = (LAS float*)lds;
    LAS float* part = (LAS float*)(lds + 65536);
    LAS float* rs = (LAS float*)(lds + 65536 + 32768);
    const int wave = tid >> 6, lane = tid & 63;
    for (int i = tid; i < 16 * 1024; i += 512) mg[i] = meta[i] * g1[i & 1023];
#pragma unroll
    for (int jj = 0; jj < 2; ++jj) { const int j = wave * 2 + jj; float s = 0.f;
        for (int k = lane; k < 1024; k += 64) { const float v = meta[j * 1024 + k]; s += v * v; }
        s = wave_sum(s); if (lane == 0) rs[j] = rsqrtf(s * (1.0f / D) + EPS); }
    __syncthreads();
    const int nn = tid & 7, kq = tid >> 3;
    float acc[16];
#pragma unroll
    for (int j = 0; j < 16; ++j) acc[j] = 0.f;
#pragma unroll 4
    for (int kk = 0; kk < 16; ++kk) { const int k = 16 * kq + kk; const float w = w_in[(size_t)k * NP + 8 * blk + nn];
#pragma unroll
        for (int j = 0; j < 16; ++j) acc[j] += mg[j * 1024 + k] * w; }
#pragma unroll
    for (int j = 0; j < 16; ++j) part[(kq * 16 + j) * 8 + nn] = acc[j];
    __syncthreads();
    if (tid < 128) { const int j = tid >> 3; float s = 0.f;
        for (int q = 0; q < 64; ++q) s += part[(q * 16 + j) * 8 + nn];
        const bf16 o = (bf16)f2bf(s * rs[j]);
#pragma unroll
        for (int b = 0; b < BATCH; ++b) P[((size_t)b * LSEQ + j) * NP + 8 * blk + nn] = o; }
    __syncthreads();
}

__device__ __forceinline__ void ld8(const bf16* p, float (&f)[8]) {
    const v4u w = *(const v4u*)p;
    f[0] = bflo(w.x); f[1] = bfhi(w.x); f[2] = bflo(w.y); f[3] = bfhi(w.y); f[4] = bflo(w.z); f[5] = bfhi(w.z); f[6] = bflo(w.w); f[7] = bfhi(w.w);
}
__device__ __forceinline__ void st8(bf16* p, const float (&f)[8]) {
    v4u o; o.x = pk2(f[0], f[1]); o.y = pk2(f[2], f[3]); o.z = pk2(f[4], f[5]); o.w = pk2(f[6], f[7]); *(v4u*)p = o;
}
__device__ __forceinline__ void p2_convpool(const bf16* P, const float* conv_w, const float* conv_b, bf16* Y, int blk, int tid) {
    const int cgp = tid & 127, run = tid >> 7;
    const int r_start = blk * 128 + run * 32;
    const int b = r_start >> 13, l0 = NMETA + (r_start & 8191);
    const bf16* Pb = P + (size_t)b * LSEQ * NP;
    if (cgp < 64) {
        const int c0 = cgp * 8;
        float w0[8], w1[8], w2[8], cb[8];
#pragma unroll
        for (int i = 0; i < 8; ++i) { w0[i] = conv_w[c0 + i]; w1[i] = conv_w[512 + c0 + i]; w2[i] = conv_w[1024 + c0 + i]; cb[i] = conv_b[c0 + i]; }
        float zp[8], zc[8], zn[8], a[8], c[8], bg[8], y[8];
        ld8(Pb + (size_t)(l0 - 1) * NP + c0, a); ld8(Pb + (size_t)(l0 - 1) * NP + 1024 + c0, c);
#pragma unroll
        for (int i = 0; i < 8; ++i) zp[i] = a[i] * c[i];
        ld8(Pb + (size_t)l0 * NP + c0, a); ld8(Pb + (size_t)l0 * NP + 1024 + c0, c);
#pragma unroll
        for (int i = 0; i < 8; ++i) zc[i] = a[i] * c[i];
        for (int t = 0; t < 32; ++t) { const int l = l0 + t;
            if (l + 1 < LSEQ) { ld8(Pb + (size_t)(l + 1) * NP + c0, a); ld8(Pb + (size_t)(l + 1) * NP + 1024 + c0, c);
#pragma unroll
                for (int i = 0; i < 8; ++i) zn[i] = a[i] * c[i]; }
            else {
#pragma unroll
                for (int i = 0; i < 8; ++i) zn[i] = 0.f; }
            ld8(Pb + (size_t)l * NP + 512 + c0, bg);
#pragma unroll
            for (int i = 0; i < 8; ++i) { y[i] = bg[i] * (w0[i] * zp[i] + w1[i] * zc[i] + w2[i] * zn[i] + cb[i]); zp[i] = zc[i]; zc[i] = zn[i]; }
            st8(Y + (size_t)(r_start + t) * D + c0, y); }
    } else {
        const int c0 = (cgp - 64) * 8, g = c0 >> 7, hw = 1 << g;
        const bf16* Hb = Pb + 1536 + c0;
        float S[8], v[8], m[8];
#pragma unroll
        for (int i = 0; i < 8; ++i) S[i] = 0.f;
        { const int hi0 = (l0 + hw < LSEQ) ? l0 + hw : LSEQ;
          for (int j = l0 - hw; j < hi0; ++j) { ld8(Hb + (size_t)j * NP, v);
#pragma unroll
              for (int i = 0; i < 8; ++i) S[i] += v[i]; } }
        for (int t = 0; t < 32; ++t) { const int l = l0 + t; const int hi = (l + hw < LSEQ) ? l + hw : LSEQ; const float inv = 1.0f / (float)(hi - (l - hw));
            ld8(Hb + (size_t)l * NP, v);
#pragma unroll
            for (int i = 0; i < 8; ++i) m[i] = S[i] * inv - v[i];
            st8(Y + (size_t)(r_start + t) * D + 512 + c0, m);
            ld8(Hb + (size_t)(l - hw) * NP, v);
#pragma unroll
            for (int i = 0; i < 8; ++i) S[i] -= v[i];
            if (l + hw < LSEQ) { ld8(Hb + (size_t)(l + hw) * NP, v);
#pragma unroll
                for (int i = 0; i < 8; ++i) S[i] += v[i]; } }
    }
}

#define MFMA32(a, b, c) __builtin_amdgcn_mfma_f32_32x32x16_bf16((a), (b), (c), 0, 0, 0)
__device__ __forceinline__ float mkcand(float a, float b, unsigned tag) { return __builtin_bit_cast(float, (__builtin_bit_cast(unsigned, a + b) & ~0xFFu) | tag); }
__device__ __forceinline__ unsigned keylook(unsigned long long lo, unsigned long long hi, unsigned i) {
    const unsigned long long w = (i < 8u) ? lo : hi;
    return (unsigned)(w >> (8u * (i & 7u))) & 127u;
}
__device__ __forceinline__ void p5_item(const bf16* Q, const bf16* KB, int* SI, float* SG, int tg, int head, int lane) {
    const int r = lane & 31, h = lane >> 5;
    const int tok = tg * 32 + r;
    const float NEG = -__builtin_inff();
    float sv[2][16];
#pragma unroll
    for (int p = 0; p < 2; ++p) {
        const int hp = head * 2 + p;
        f32x16 acc[4];
#pragma unroll
        for (int kt = 0; kt < 4; ++kt)
#pragma unroll
            for (int i = 0; i < 16; ++i) acc[kt][i] = 0.f;
        const bf16* qrow = Q + (size_t)tok * NQ + hp * 128 + 8 * h;
        const bf16* kb = KB + ((size_t)hp * 128 + r) * 128 + 8 * h;
#pragma unroll 2
        for (int s = 0; s < 8; ++s) {
            const bf16x8 bq = *(const bf16x8*)(qrow + 16 * s);
#pragma unroll
            for (int kt = 0; kt < 4; ++kt) { const bf16x8 ak = *(const bf16x8*)(kb + (size_t)kt * 32 * 128 + 16 * s); acc[kt] = MFMA32(ak, bq, acc[kt]); }
        }
        __builtin_amdgcn_sched_barrier(0);
        float v[64];
#pragma unroll
        for (int kt = 0; kt < 4; ++kt)
#pragma unroll
            for (int i = 0; i < 16; ++i) { const unsigned key = 32u * kt + (i & 3) + 8u * (i >> 2) + 4u * h;
                const float av = acc[kt][i];
                v[kt * 16 + i] = __builtin_bit_cast(float, (__builtin_bit_cast(unsigned, av) & ~127u) | key); }
#pragma unroll
        for (int t = 0; t < 16; ++t) {
            float m = v[0];
#pragma unroll
            for (int i = 1; i < 64; ++i) m = fmaxf(m, v[i]);
            m = fmaxf(m, __shfl_xor(m, 32));
            sv[p][t] = m;
            const unsigned mb = __builtin_bit_cast(unsigned, m);
#pragma unroll
            for (int i = 0; i < 64; ++i) v[i] = (__builtin_bit_cast(unsigned, v[i]) == mb) ? NEG : v[i];
        }
        __builtin_amdgcn_sched_barrier(0);
    }
    float cv[50];
#define P5_CROW(I, NJ, BASE) _Pragma("unroll") for (int j = 0; j < NJ; ++j) cv[BASE + j] = mkcand(sv[0][I], sv[1][j], (unsigned)((I << 4) | j));
    P5_CROW(0, 16, 0) P5_CROW(1, 8, 16) P5_CROW(2, 5, 24) P5_CROW(3, 4, 29) P5_CROW(4, 3, 33) P5_CROW(5, 2, 36) P5_CROW(6, 2, 38) P5_CROW(7, 2, 40)
    P5_CROW(8, 1, 42) P5_CROW(9, 1, 43) P5_CROW(10, 1, 44) P5_CROW(11, 1, 45) P5_CROW(12, 1, 46) P5_CROW(13, 1, 47) P5_CROW(14, 1, 48) P5_CROW(15, 1, 49)
#undef P5_CROW
    unsigned long long K0lo = 0ull, K0hi = 0ull, K1lo = 0ull, K1hi = 0ull;
#pragma unroll
    for (int i = 0; i < 8; ++i) {
        K0lo |= (unsigned long long)(__builtin_bit_cast(unsigned, sv[0][i]) & 127u) << (8 * i); K0hi |= (unsigned long long)(__builtin_bit_cast(unsigned, sv[0][8 + i]) & 127u) << (8 * i);
        K1lo |= (unsigned long long)(__builtin_bit_cast(unsigned, sv[1][i]) & 127u) << (8 * i); K1hi |= (unsigned long long)(__builtin_bit_cast(unsigned, sv[1][8 + i]) & 127u) << (8 * i); }
    float sel[16];
#pragma unroll
    for (int t = 0; t < 16; ++t) {
        float m = cv[0];
#pragma unroll
        for (int i = 1; i < 50; ++i) m = fmaxf(m, cv[i]);
        sel[t] = m;
        const unsigned mb = __builtin_bit_cast(unsigned, m);
#pragma unroll
        for (int i = 0; i < 50; ++i) cv[i] = (__builtin_bit_cast(unsigned, cv[i]) == mb) ? NEG : cv[i];
    }
    float e[16], esum = 0.f; int eidx[16];
#pragma unroll
    for (int t = 0; t < 16; ++t) { e[t] = __expf(sel[t] - sel[0]); esum += e[t];
        const unsigned tag = __builtin_bit_cast(unsigned, sel[t]) & 0xFFu;
        eidx[t] = (int)(keylook(K0lo, K0hi, tag >> 4) * 128u + keylook(K1lo, K1hi, tag & 15u)); }
    const float inv = 1.0f / esum;
    if (h == 0) { int* o = SI + (size_t)tok * 128 + head * 16;
#pragma unroll
        for (int t = 0; t < 16; t += 4) *(int4*)(o + t) = make_int4(eidx[t], eidx[t + 1], eidx[t + 2], eidx[t + 3]); }
    else { float* o = SG + (size_t)tok * 128 + head * 16;
#pragma unroll
        for (int t = 0; t < 16; t += 4) *(f32x4*)(o + t) = (f32x4){e[t] * inv, e[t + 1] * inv, e[t + 2] * inv, e[t + 3] * inv}; }
}


__device__ __forceinline__ float wave_max(float v) {
#pragma unroll
    for (int o = 1; o < 64; o <<= 1) v = fmaxf(v, __shfl_xor(v, o));
    return v;
}
__device__ __forceinline__ float pick4(float a, float b, float c, float d, int k) { return (k < 2) ? ((k == 0) ? a : b) : ((k == 2) ? c : d); }
__device__ __forceinline__ void p5_simple(const bf16* Q, const bf16* KB, int* SI, float* SG, int tok, int head, int lane) {
    const float NEG = -__builtin_inff();
    float s[2][2];
#pragma unroll
    for (int p = 0; p < 2; ++p) { const int hp = head * 2 + p; const bf16* qrow = Q + (size_t)tok * NQ + hp * 128;
#pragma unroll
        for (int kk = 0; kk < 2; ++kk) { const unsigned key = lane + 64 * kk; const bf16* kr = KB + ((size_t)hp * 128 + key) * 128; float acc = 0.f;
            for (int d = 0; d < 128; d += 8) { float qf[8], kf[8]; ld8(qrow + d, qf); ld8(kr + d, kf);
#pragma unroll
                for (int i = 0; i < 8; ++i) acc += qf[i] * kf[i]; }
            s[p][kk] = __builtin_bit_cast(float, (__builtin_bit_cast(unsigned, acc) & ~127u) | key); } }
    float sv[2][16];
#pragma unroll
    for (int p = 0; p < 2; ++p)
#pragma unroll
        for (int t = 0; t < 16; ++t) { const float m = wave_max(fmaxf(s[p][0], s[p][1])); sv[p][t] = m; const unsigned mb = __builtin_bit_cast(unsigned, m);
            s[p][0] = (__builtin_bit_cast(unsigned, s[p][0]) == mb) ? NEG : s[p][0]; s[p][1] = (__builtin_bit_cast(unsigned, s[p][1]) == mb) ? NEG : s[p][1]; }
    const int j = lane & 15, ib = lane >> 4;
    float s1j = sv[1][0];
#pragma unroll
    for (int jj = 1; jj < 16; ++jj) s1j = (j == jj) ? sv[1][jj] : s1j;
    float cv[4];
#pragma unroll
    for (int q = 0; q < 4; ++q) { const float s0i = pick4(sv[0][4 * q], sv[0][4 * q + 1], sv[0][4 * q + 2], sv[0][4 * q + 3], ib);
        cv[q] = mkcand(s0i, s1j, (unsigned)(((4 * q + ib) << 4) | j)); }
    unsigned long long K0lo = 0ull, K0hi = 0ull, K1lo = 0ull, K1hi = 0ull;
#pragma unroll
    for (int i = 0; i < 8; ++i) {
        K0lo |= (unsigned long long)(__builtin_bit_cast(unsigned, sv[0][i]) & 127u) << (8 * i); K0hi |= (unsigned long long)(__builtin_bit_cast(unsigned, sv[0][8 + i]) & 127u) << (8 * i);
        K1lo |= (unsigned long long)(__builtin_bit_cast(unsigned, sv[1][i]) & 127u) << (8 * i); K1hi |= (unsigned long long)(__builtin_bit_cast(unsigned, sv[1][8 + i]) & 127u) << (8 * i); }
    float sel[16];
#pragma unroll
    for (int t = 0; t < 16; ++t) { const float m = wave_max(fmaxf(fmaxf(cv[0], cv[1]), fmaxf(cv[2], cv[3]))); sel[t] = m; const unsigned mb = __builtin_bit_cast(unsigned, m);
#pragma unroll
        for (int q = 0; q < 4; ++q) cv[q] = (__builtin_bit_cast(unsigned, cv[q]) == mb) ? NEG : cv[q]; }
    float e[16], esum = 0.f; int eidx[16];
#pragma unroll
    for (int t = 0; t < 16; ++t) { e[t] = __expf(sel[t] - sel[0]); esum += e[t];
        const unsigned tag = __builtin_bit_cast(unsigned, sel[t]) & 0xFFu;
        eidx[t] = (int)(keylook(K0lo, K0hi, tag >> 4) * 128u + keylook(K1lo, K1hi, tag & 15u)); }
    const float inv = 1.0f / esum;
    if (lane == 0) { int* o = SI + (size_t)tok * 128 + head * 16; float* og = SG + (size_t)tok * 128 + head * 16;
#pragma unroll
        for (int t = 0; t < 16; ++t) { o[t] = eidx[t]; og[t] = e[t] * inv; } }
}

__device__ __forceinline__ f32x2 cvt8(unsigned w, bool hi) { return hi ? __builtin_amdgcn_cvt_pk_f32_fp8((int)w, true) : __builtin_amdgcn_cvt_pk_f32_fp8((int)w, false); }
#define P6_LOAD(UB_, VB_, E0) do { _Pragma("unroll") for (int k = 0; k < 8; ++k) { const int e_ = (E0) + k; \
        const int idx_ = __builtin_amdgcn_readlane(((E0) < 64) ? id0 : id1, e_ & 63); \
        UB_[k] = ((const v4u*)(U8 + (size_t)idx_ * D))[lane]; VB_[k] = ((const v4u*)(V8 + (size_t)idx_ * D))[lane]; } } while (0)
#define P6_COMPUTE(UB_, VB_, E0) do { float d_[8]; \
        _Pragma("unroll") for (int k = 0; k < 8; ++k) { f32x2 a2 = {0.f, 0.f}; const unsigned uw_[4] = {UB_[k].x, UB_[k].y, UB_[k].z, UB_[k].w}; \
            _Pragma("unroll") for (int j = 0; j < 4; ++j) { a2 = cvt8(uw_[j], false) * x2[2 * j] + a2; a2 = cvt8(uw_[j], true) * x2[2 * j + 1] + a2; } \
            d_[k] = a2.x + a2.y; } \
        float r_[4], q_[2]; \
        _Pragma("unroll") for (int i = 0; i < 4; ++i) { const float a_ = h5 ? d_[2 * i + 1] : d_[2 * i], b_ = h5 ? d_[2 * i] : d_[2 * i + 1]; r_[i] = a_ + __shfl_xor(b_, 32); } \
        _Pragma("unroll") for (int i = 0; i < 2; ++i) { const float a_ = h4 ? r_[2 * i + 1] : r_[2 * i], b_ = h4 ? r_[2 * i] : r_[2 * i + 1]; q_[i] = a_ + __shfl_xor(b_, 16); } \
        float s_; { const float a_ = h3 ? q_[1] : q_[0], b_ = h3 ? q_[0] : q_[1]; s_ = a_ + __shfl_xor(b_, 8); } \
        s_ += __shfl_xor(s_, 4); s_ += __shfl_xor(s_, 2); s_ += __shfl_xor(s_, 1); \
        const float gl_ = __shfl(((E0) < 64) ? g0 : g1, ((E0) + kl) & 63); \
        const float a_ = s_ * ascale; \
        const float wv_ = gl_ * 0.5f * a_ * (1.0f + erff(a_ * 0.70710678118654752f)) * (1.0f / V8_SCALE); \
        _Pragma("unroll") for (int k = 0; k < 8; ++k) { const float w_ = __builtin_bit_cast(float, __builtin_amdgcn_readlane(__builtin_bit_cast(int, wv_), 32 * (k & 1) + 16 * ((k >> 1) & 1) + 8 * ((k >> 2) & 1))); \
            const unsigned vw_[4] = {VB_[k].x, VB_[k].y, VB_[k].z, VB_[k].w}; \
            _Pragma("unroll") for (int j = 0; j < 4; ++j) { o2[2 * j] = cvt8(vw_[j], false) * w_ + o2[2 * j]; o2[2 * j + 1] = cvt8(vw_[j], true) * w_ + o2[2 * j + 1]; } } } while (0)
__device__ __forceinline__ void p6_token(const bf16* H2B, const float* rowss, const int* SI, const float* SG, const unsigned char* U8, const unsigned char* V8, const float* gf, float* OUT, int tok, int lane) {
    const v4u* hb = (const v4u*)(H2B + (size_t)tok * D) + 2 * lane;
    const v4u xa = hb[0], xb = hb[1];
    const unsigned xw[8] = {xa.x, xa.y, xa.z, xa.w, xb.x, xb.y, xb.z, xb.w};
    f32x2 x2[8], o2[8];
#pragma unroll
    for (int j = 0; j < 8; ++j) { x2[j] = (f32x2){bflo(xw[j]), bfhi(xw[j])}; o2[j] = (f32x2){0.f, 0.f}; }
    const float ascale = rsqrtf(rowss[tok] * (1.0f / D) + EPS) * (1.0f / U8_SCALE);
    const int id0 = SI[(size_t)tok * 128 + lane], id1 = SI[(size_t)tok * 128 + 64 + lane];
    const float g0 = SG[(size_t)tok * 128 + lane], g1 = SG[(size_t)tok * 128 + 64 + lane];
    const bool h5 = (lane & 32) != 0, h4 = (lane & 16) != 0, h3 = (lane & 8) != 0;
    const int kl = ((lane >> 5) & 1) + 2 * ((lane >> 4) & 1) + 4 * ((lane >> 3) & 1);
    v4u uA[8], vA[8], uB[8], vB[8];
    P6_LOAD(uA, vA, 0);
    for (int e0 = 0; e0 < 128; e0 += 16) {
        P6_LOAD(uB, vB, e0 + 8);
        P6_COMPUTE(uA, vA, e0);
        if (e0 + 16 < 128) P6_LOAD(uA, vA, e0 + 16);
        P6_COMPUTE(uB, vB, e0 + 8);
    }
    f32x4* op = (f32x4*)(OUT + (size_t)tok * D) + 4 * lane;
    const f32x4* gp = (const f32x4*)gf + 4 * lane;
    f32x4 y[4]; float ss = 0.f;
#pragma unroll
    for (int q = 0; q < 4; ++q) { const f32x4 hv = op[q]; y[q] = (f32x4){hv.x + o2[2 * q].x, hv.y + o2[2 * q].y, hv.z + o2[2 * q + 1].x, hv.w + o2[2 * q + 1].y};
        ss += (y[q].x * y[q].x + y[q].y * y[q].y) + (y[q].z * y[q].z + y[q].w * y[q].w); }
    ss = wave_sum(ss);
    const float rs = rsqrtf(ss * (1.0f / D) + EPS);
#pragma unroll
    for (int q = 0; q < 4; ++q) op[q] = y[q] * rs * gp[q];
}

struct Args { const float* in[15]; float* out; unsigned char* ws; int ph_lo, ph_hi; };
constexpr int NPHASE = 7;
#ifndef MK_N_LAUNCHES
#define MK_N_LAUNCHES 1
#endif

__global__ void __launch_bounds__(NWAVES * 64, 2) fwd_kernel(Args args) {
    extern __shared__ __attribute__((aligned(16))) unsigned char lds_raw[];
    LAS unsigned char* lds = (LAS unsigned char*)lds_raw;
    volatile LAS unsigned* MISC = (volatile LAS unsigned*)(lds + MISC_OFF);
    const int tid = threadIdx.x, lane = tid & 63, wave = __builtin_amdgcn_readfirstlane(tid >> 6);
    const int G = gridDim.x, blk = blockIdx.x;
    unsigned char* ws = args.ws;
    const float* x = args.in[0]; const float* meta = args.in[1]; const float* g1 = args.in[2]; const float* w_in = args.in[3];
    const float* conv_w = args.in[4]; const float* conv_b = args.in[5]; const float* pool_w = args.in[6]; const float* pool_scale = args.in[7];
    const float* w_out = args.in[8]; const float* g2 = args.in[9]; const float* w_q = args.in[10]; const float* keys = args.in[11];
    const float* pu = args.in[12]; const float* pv = args.in[13]; const float* gf = args.in[14];
    bf16* WinT = (bf16*)(ws + WS_WIN); bf16* WoutT = (bf16*)(ws + WS_WOUT); bf16* WqT = (bf16*)(ws + WS_WQ); bf16* KB = (bf16*)(ws + WS_KEYS);
    float* rstd1 = (float*)(ws + WS_RSTD1); float* rowss = (float*)(ws + WS_ROWSS);
    unsigned char* U8 = ws + WS_UB; unsigned char* V8 = ws + WS_VB; bf16* XB = (bf16*)(ws + WS_XB); bf16* YP = (bf16*)(ws + WS_XB);
    bf16* P = (bf16*)(ws + WS_P); bf16* Qb = (bf16*)(ws + WS_P); bf16* H2B = (bf16*)(ws + WS_H2B);
    int* SI = (int*)(ws + WS_SELI); float* SG = (float*)(ws + WS_SELG);

    for (int u = tid; u < (LDS_BYTES - RING_BYTES) / 4; u += NWAVES * 64) ((LAS unsigned*)(lds + RING_BYTES))[u] = 0u;
    __syncthreads();
    const int lo = args.ph_lo, hi = args.ph_hi;
    XcdBarrier bar; bar.bar = (unsigned*)(ws + WS_CTL) + CW_BAR; bar.x = 0; bar.st = nullptr;
    if (hi - lo > 1) bar = xcd_barrier_post((unsigned*)(ws + WS_CTL) + CW_BAR, MISC + 8);
#define IN(k) (lo <= (k) && (k) < hi)
#define SEAM(k) do { if (IN(k) && IN((k) + 1)) xcd_barrier(bar); } while (0)
    const int gw = blk * NWAVES + wave, NGW = G * NWAVES;

    if (IN(0)) {
        for (int mb = blk; mb < 256; mb += G) p0_meta(meta, g1, w_in, P, lds, mb, tid);
        LAS float* scr = (LAS float*)(lds + wave * 16384);
        for (int it = gw; it < 1024 + 1024 + 256 + 1024; it += NGW) {
            int r = __builtin_amdgcn_readfirstlane(it);
            if (r < 1024) { p0_transpose_item(w_in, D, NP, g1, WinT, scr, r, lane); continue; } r -= 1024;
            if (r < 1024) { p0_transpose_item(w_q, D, NQ, g2, WqT, scr, r, lane); continue; } r -= 1024;
            if (r < 256) { p0_transpose_item(w_out, D, D, nullptr, WoutT, scr, r, lane); continue; } r -= 256;
            p0_weff_item(w_out, pool_w, pool_scale, WoutT, r, lane);
        }
        for (int m = gw; m < T; m += NGW) row_to_bf16(x + (size_t)m * D, XB + (size_t)m * D, nullptr, rstd1 + m, lane);
        for (int m = gw; m < NEXP; m += NGW) { row_to_fp8(pu + (size_t)m * D, U8 + (size_t)m * D, g2, U8_SCALE, lane); row_to_fp8(pv + (size_t)m * D, V8 + (size_t)m * D, nullptr, V8_SCALE, lane); }
        for (int m = gw; m < 256; m += NGW) row_to_bf16(keys + (size_t)m * D, KB + (size_t)m * D, nullptr, nullptr, lane);
    }
    SEAM(0);
    if (IN(1)) {
        pg8::Gemm g{XB, WinT, T, NP, D}; pg8::StaticOrder S; S.init(T, NP, G, blk);
        EpiP E{P, rstd1};
        pg8::gemm_phase<EpiP, pg8::StaticOrder, true, true>(lds, g, S, E);
    }
    SEAM(1);
    if (IN(2)) {
        for (int b2 = blk; b2 < T / 128; b2 += G) p2_convpool(P, conv_w, conv_b, YP, b2, tid);
    }
    SEAM(2);
    if (IN(3)) {
        pg8::Gemm g{YP, WoutT, T, D, D}; pg8::StaticOrder S; S.init(T, D, G, blk);
        EpiH2 E{x, args.out, H2B, rowss};
        pg8::gemm_phase<EpiH2, pg8::StaticOrder, true, true>(lds, g, S, E);
    }
    SEAM(3);
    if (IN(4)) {
        pg8::Gemm g{H2B, WqT, T, NQ, D}; pg8::StaticOrder S; S.init(T, NQ, G, blk);
        EpiQ E{Qb, rowss};
        pg8::gemm_phase<EpiQ, pg8::StaticOrder, true, true>(lds, g, S, E);
    }
    SEAM(4);
    if (IN(5)) {
#ifdef P5_SIMPLE
        for (int it = gw; it < T * 8; it += NGW) p5_simple(Qb, KB, SI, SG, it >> 3, it & 7, lane);
#else
        for (int it = gw; it < (T / 32) * 8; it += NGW) p5_item(Qb, KB, SI, SG, it >> 3, it & 7, lane);
#endif
    }
    SEAM(5);
    if (IN(6)) {
        for (int tok = gw; tok < T; tok += NGW) p6_token(H2B, rowss, SI, SG, U8, V8, gf, args.out, tok, lane);
    }
#undef IN
#undef SEAM
}

extern "C" void kernel_launch(void* const* d_in, const int* in_sizes, int n_in, void* d_out, int out_size, void* d_ws, size_t ws_size, hipStream_t stream) {
    static int grid = 0;
    if (grid == 0) {
        if (n_in != 15 || out_size != T * D || ws_size < WS_END) { fprintf(stderr, "kernel_launch: unexpected shapes: n_in %d out %d ws %zu (need %zu)\n", n_in, out_size, ws_size, (size_t)WS_END); grid = -1; return; }
        int dev = 0, cus = 0, per_cu = 0;
        if (hipGetDevice(&dev) != hipSuccess || hipDeviceGetAttribute(&cus, hipDeviceAttributeMultiprocessorCount, dev) != hipSuccess) { grid = -1; return; }
        if (hipFuncSetAttribute((const void*)fwd_kernel, hipFuncAttributeMaxDynamicSharedMemorySize, LDS_BYTES) != hipSuccess) { fprintf(stderr, "kernel_launch: hipFuncSetAttribute failed\n"); grid = -1; return; }
        if (hipOccupancyMaxActiveBlocksPerMultiprocessor(&per_cu, (const void*)fwd_kernel, NWAVES * 64, LDS_BYTES) != hipSuccess || per_cu < 1) fprintf(stderr, "kernel_launch: occupancy query says %d\n", per_cu);
        (void)hipGetLastError();
        grid = cus;
    }
    if (grid < 0) return;
    (void)hipMemsetAsync((char*)d_ws + WS_CTL, 0, CTL_ZERO_BYTES, stream);
    Args a{};
    for (int i = 0; i < 15; ++i) a.in[i] = (const float*)d_in[i];
    a.out = (float*)d_out; a.ws = (unsigned char*)d_ws;
#if MK_N_LAUNCHES == 1
    a.ph_lo = 0; a.ph_hi = NPHASE;
    hipLaunchKernelGGL(fwd_kernel, dim3(grid), dim3(NWAVES * 64), LDS_BYTES, stream, a);
#else
    for (int li = 0; li < NPHASE; ++li) { a.ph_lo = li; a.ph_hi = li + 1;
        hipLaunchKernelGGL(fwd_kernel, dim3(grid), dim3(NWAVES * 64), LDS_BYTES, stream, a); }
#endif
}
```

```cpp
#include <hip/hip_runtime.h>
#include <cstdio>
#include <cstdint>
namespace pg8 {
#define PG8_LAS __attribute__((address_space(3)))
typedef unsigned short bf16_t;
typedef short bf16x8 __attribute__((ext_vector_type(8)));
typedef float f32x4 __attribute__((ext_vector_type(4)));
typedef unsigned u32x4 __attribute__((ext_vector_type(4)));
constexpr int BM = 256, BK = 64, HALF = 128, HTB = HALF * BK * 2  , STAGE_BYTES = 8 * HTB, NXCD = 8, WGM = 8;

__host__ __device__ __forceinline__ int lds_byte(int r, int c) { const int st = (r >> 4) * 2 + (c >> 5), rr = r & 15, cc = c & 31, ob = rr * 64 + cc * 2; return st * 1024 + (ob ^ (((ob >> 9) & 1) << 5)); }
__host__ __device__ __forceinline__ void stage_rc(int b, int& R, int& C) { const int st = b / 1024, sb = b % 1024, swz = sb ^ (((sb >> 9) & 1) << 5); R = (st >> 1) * 16 + swz / 64; C = (st & 1) * 32 + (swz % 64) / 2; }
__host__ __device__ __forceinline__ int perm32(int rho) { const int n = rho >> 4, i = rho & 15; return 8 * (i >> 2) + 4 * n + (i & 3); }

struct Unit { int pm, pn; };
struct Gemm { const bf16_t* A; const bf16_t* Bt; int M, N, K; };

struct StaticOrder {
    int nM, nN, nwg, G, c;
    __host__ __device__ void init(int M, int N, int G_, int c_) { nM = M / BM; nN = N / BM; nwg = nM * nN; G = G_; c = c_; }
    __host__ __device__ bool next(int i, Unit& u) const {
        const long L = (long)i * G + c; if (L >= nwg) return false;
        int wgid = (int)L; { const int q = nwg / NXCD, r = nwg % NXCD, xcd = wgid % NXCD, off = wgid / NXCD; wgid = (xcd < r ? xcd * (q + 1) : r * (q + 1) + (xcd - r) * q) + off; }
        const int nig = WGM * nN, gid = wgid / nig, fm = gid * WGM, gsz = (nM - fm) < WGM ? (nM - fm) : WGM;
        u.pm = fm + ((wgid % nig) % gsz); u.pn = (wgid % nig) / gsz; return true;
    }
    __device__ __forceinline__ void a_ready(const Unit&) const {}
    __device__ __forceinline__ void done(const Unit&) const {}
};

__device__ __forceinline__ unsigned cvt_pk_bf16(float lo, float hi) { unsigned r; asm volatile("v_cvt_pk_bf16_f32 %0, %1, %2" : "=v"(r) : "v"(lo), "v"(hi)); return r; }
template <class Epi, class Sched, bool ALIGN_EPI = false, bool SP2 = false>
__device__ __forceinline__ void gemm_phase(PG8_LAS unsigned char* lds, const Gemm g, const Sched& S, const Epi& E) {
    const int tid = threadIdx.x, wid = __builtin_amdgcn_readfirstlane(tid >> 6), lane = tid & 63, wr = wid >> 2, wc = wid & 3, fr = lane & 15, fq = lane >> 4;
    const int K = g.K, nt = K / BK;
    unsigned voffA[2], voffB[2];
#pragma unroll
    for (int i = 0; i < 2; ++i) { int R, C; stage_rc(tid * 16 + i * 8192, R, C); const int Rb = Epi::PERM ? ((R & ~31) + perm32(R & 31)) : R;
        voffA[i] = (unsigned)(R * K + C) * 2u; voffB[i] = (unsigned)(Rb * K + C) * 2u; }
    const size_t kstep = (size_t)(BK * 2);
    const size_t hstep = (size_t)HALF * K * 2;
    const size_t tstep = 2 * hstep;
    const unsigned ldsw = (unsigned)wid * 1024u;
    const int aoff = lds_byte(wr * 64 + fr, fq * 8), boff = lds_byte(wc * 32 + fr, fq * 8);
#define PG8_SA(b, h) (((b) * 2 + (h)) * HTB)
#define PG8_SB(b, h) ((4 + (b) * 2 + (h)) * HTB)
#define PG8_STAGE(bufoff, gbase, voff) do { _Pragma("unroll") for (int _i = 0; _i < 2; ++_i) \
        __builtin_amdgcn_global_load_lds((const unsigned*)((const char*)(gbase) + (voff)[_i]), (PG8_LAS unsigned*)(lds + (bufoff) + ldsw + _i * 8192), 16, 0, 0); } while (0)
#define PG8_LDA(dst, b, h) do { _Pragma("unroll") for (int m = 0; m < 4; ++m) _Pragma("unroll") for (int k = 0; k < 2; ++k) dst[m][k] = *(const PG8_LAS bf16x8*)(lds + PG8_SA(b, h) + aoff + m * 2048 + k * 1024); } while (0)
#define PG8_LDB(dst, b, h) do { _Pragma("unroll") for (int n = 0; n < 2; ++n) _Pragma("unroll") for (int k = 0; k < 2; ++k) dst[n][k] = *(const PG8_LAS bf16x8*)(lds + PG8_SB(b, h) + boff + n * 2048 + k * 1024); } while (0)
#define PG8_MMA(ai, bj, At, Bt) do { __builtin_amdgcn_s_setprio(1); _Pragma("unroll") for (int m = 0; m < 4; ++m) _Pragma("unroll") for (int n = 0; n < 2; ++n) _Pragma("unroll") for (int k = 0; k < 2; ++k) \
        acc[ai][bj][m][n] = __builtin_amdgcn_mfma_f32_16x16x32_bf16(Bt[n][k], At[m][k], acc[ai][bj][m][n], 0, 0, 0); __builtin_amdgcn_s_setprio(0); } while (0)
#define PG8_WAIT_V(n) asm volatile("s_waitcnt vmcnt(" #n ")" ::: "memory")
#define PG8_WAIT_L(n) asm volatile("s_waitcnt lgkmcnt(" #n ")" ::: "memory")
#define PG8_BAR __builtin_amdgcn_s_barrier()
#define PG8_SCHED __builtin_amdgcn_sched_barrier(0)
    Unit cur, nxt; int ui = 0;
    if (!S.next(0, cur)) return;
    f32x4 acc[2][2][4][2];
#pragma unroll
    for (int a = 0; a < 2; ++a)
#pragma unroll
        for (int b = 0; b < 2; ++b)
#pragma unroll
            for (int m = 0; m < 4; ++m)
#pragma unroll
                for (int n = 0; n < 2; ++n) acc[a][b][m][n] = (f32x4){0.f, 0.f, 0.f, 0.f};
    bf16x8 At[4][2], B0[2][2], B1[2][2];
    const char* cA = (const char*)g.A + (size_t)cur.pm * tstep; const char* cB = (const char*)g.Bt + (size_t)cur.pn * tstep;
    S.a_ready(cur);
    if constexpr (SP2) {
        PG8_STAGE(PG8_SB(0, 0), cB, voffB); PG8_STAGE(PG8_SB(0, 1), cB + hstep, voffB); PG8_STAGE(PG8_SA(0, 0), cA, voffA); PG8_STAGE(PG8_SA(0, 1), cA + hstep, voffA);
        if (wr == 1) PG8_BAR;
        PG8_WAIT_V(2); PG8_BAR;
        PG8_STAGE(PG8_SB(1, 0), cB + kstep, voffB); PG8_STAGE(PG8_SA(1, 0), cA + kstep, voffA); PG8_STAGE(PG8_SB(1, 1), cB + hstep + kstep, voffB);
        PG8_WAIT_V(6); PG8_BAR;
    } else {
        PG8_STAGE(PG8_SB(0, 0), cB, voffB); PG8_STAGE(PG8_SA(0, 0), cA, voffA); PG8_STAGE(PG8_SB(0, 1), cB + hstep, voffB); PG8_STAGE(PG8_SA(0, 1), cA + hstep, voffA);
        if (wr == 1) PG8_BAR;
        PG8_WAIT_V(4); PG8_BAR;
        PG8_STAGE(PG8_SB(1, 0), cB + kstep, voffB); PG8_STAGE(PG8_SA(1, 0), cA + kstep, voffA); PG8_STAGE(PG8_SB(1, 1), cB + hstep + kstep, voffB);
        PG8_WAIT_V(6); PG8_BAR;
    }
    for (;;) {
        const bool has_next = S.next(ui + 1, nxt);
        const char* nA = has_next ? (const char*)g.A + (size_t)nxt.pm * tstep : cA; const char* nB = has_next ? (const char*)g.Bt + (size_t)nxt.pn * tstep : cB;
        for (int t = 0; t < nt; t += 2) {
            const bool last = (t == nt - 2);
            const char* a1 = cA + (size_t)(t + 1) * kstep;
            const char* a2 = last ? nA : cA + (size_t)(t + 2) * kstep; const char* b2 = last ? nB : cB + (size_t)(t + 2) * kstep;
            const char* a3 = a2 + kstep; const char* b3 = b2 + kstep;
            if (last && has_next) S.a_ready(nxt);
            if constexpr (SP2) {
            PG8_LDB(B0, 0, 0); PG8_LDB(B1, 0, 1); PG8_SCHED; PG8_LDA(At, 0, 0); PG8_STAGE(PG8_SA(1, 1), a1 + hstep, voffA);
            PG8_WAIT_V(8); PG8_WAIT_L(0); PG8_BAR; PG8_MMA(0, 0, At, B0); PG8_MMA(0, 1, At, B1); PG8_BAR; PG8_SCHED;
            PG8_LDA(At, 0, 1); PG8_STAGE(PG8_SB(0, 0), b2, voffB); PG8_STAGE(PG8_SB(0, 1), b2 + hstep, voffB); PG8_STAGE(PG8_SA(0, 0), a2, voffA);
            PG8_WAIT_V(8); PG8_WAIT_L(0); PG8_BAR; PG8_MMA(1, 0, At, B0); PG8_MMA(1, 1, At, B1); PG8_BAR; PG8_SCHED;
            PG8_LDB(B0, 1, 0); PG8_LDB(B1, 1, 1); PG8_SCHED; PG8_LDA(At, 1, 0); PG8_STAGE(PG8_SA(0, 1), a2 + hstep, voffA);
            PG8_WAIT_V(8); PG8_WAIT_L(0); PG8_BAR; PG8_MMA(0, 0, At, B0); PG8_MMA(0, 1, At, B1); PG8_BAR; PG8_SCHED;
            PG8_LDA(At, 1, 1); PG8_STAGE(PG8_SB(1, 0), b3, voffB); PG8_STAGE(PG8_SB(1, 1), b3 + hstep, voffB); PG8_STAGE(PG8_SA(1, 0), a3, voffA);
            PG8_WAIT_V(8); PG8_WAIT_L(0); PG8_BAR; PG8_MMA(1, 0, At, B0); PG8_MMA(1, 1, At, B1); PG8_BAR; PG8_SCHED;
            } else {
            PG8_LDB(B0, 0, 0); PG8_SCHED; PG8_LDA(At, 0, 0); PG8_STAGE(PG8_SA(1, 1), a1 + hstep, voffA);
            PG8_WAIT_L(8); PG8_BAR; PG8_WAIT_L(0); PG8_MMA(0, 0, At, B0); PG8_BAR; PG8_SCHED;
            PG8_LDB(B1, 0, 1); PG8_STAGE(PG8_SB(0, 0), b2, voffB);
            PG8_BAR; PG8_WAIT_L(0); PG8_MMA(0, 1, At, B1); PG8_BAR;
            PG8_LDA(At, 0, 1); PG8_STAGE(PG8_SA(0, 0), a2, voffA);
            PG8_BAR; PG8_WAIT_L(0); PG8_MMA(1, 0, At, B0); PG8_BAR; PG8_SCHED;
            PG8_STAGE(PG8_SB(0, 1), b2 + hstep, voffB);
            PG8_WAIT_V(6); PG8_BAR; PG8_MMA(1, 1, At, B1); PG8_BAR;
            PG8_LDB(B0, 1, 0); PG8_SCHED; PG8_LDA(At, 1, 0); PG8_STAGE(PG8_SA(0, 1), a2 + hstep, voffA);
            PG8_WAIT_L(8); PG8_BAR; PG8_WAIT_L(0); PG8_MMA(0, 0, At, B0); PG8_BAR; PG8_SCHED;
            PG8_LDB(B1, 1, 1); PG8_STAGE(PG8_SB(1, 0), b3, voffB);
            PG8_BAR; PG8_WAIT_L(0); PG8_MMA(0, 1, At, B1); PG8_BAR;
            PG8_LDA(At, 1, 1); PG8_STAGE(PG8_SA(1, 0), a3, voffA);
            PG8_BAR; PG8_WAIT_L(0); PG8_MMA(1, 0, At, B0); PG8_BAR; PG8_SCHED;
            PG8_STAGE(PG8_SB(1, 1), b3 + hstep, voffB);
            PG8_WAIT_V(6); PG8_BAR; PG8_MMA(1, 1, At, B1); PG8_BAR;
            }
        }
        if constexpr (ALIGN_EPI) { if (wr == 0) PG8_BAR; }
        if constexpr (!Epi::AFTER_DRAIN) { E(acc, cur, wr, wc, fr, fq); S.done(cur); }
        if (!has_next) break;
#pragma unroll
        for (int a = 0; a < 2; ++a)
#pragma unroll
            for (int b = 0; b < 2; ++b)
#pragma unroll
                for (int m = 0; m < 4; ++m)
#pragma unroll
                    for (int n = 0; n < 2; ++n) acc[a][b][m][n] = (f32x4){0.f, 0.f, 0.f, 0.f};
        cur = nxt; cA = nA; cB = nB; ++ui;
        if constexpr (ALIGN_EPI) { if (wr == 1) PG8_BAR; }
    }
    PG8_WAIT_V(0);
    if constexpr (!ALIGN_EPI) { if (wr == 0) PG8_BAR; }
    PG8_BAR;
    if constexpr (Epi::AFTER_DRAIN) { E.fused(acc, cur, wr, wc, fr, fq, lds, wid, lane); S.done(cur); }
#undef PG8_SA
#undef PG8_SB
#undef PG8_STAGE
#undef PG8_LDA
#undef PG8_LDB
#undef PG8_MMA
#undef PG8_WAIT_V
#undef PG8_WAIT_L
#undef PG8_BAR
#undef PG8_SCHED
}
}

#define GAS __attribute__((address_space(1)))
#define LAS __attribute__((address_space(3)))
#define XB_TMO      128
#define XB_XCNT(j)  (256  + 64 * (j))
#define XB_XSUB(j)  (1280 + 64 * (j))
#define XB_XGEN(j)  (2304 + 64 * (j))
#define XB_TOP      3328
#define XB_TOPGEN   3392
#define XCD_BAR_WORDS 3456
#define XB_SPIN_CAP (1u << 18)

__device__ __forceinline__ unsigned xb_ld(unsigned* p)              { return __hip_atomic_load(p, __ATOMIC_RELAXED, __HIP_MEMORY_SCOPE_AGENT); }
__device__ __forceinline__ unsigned xb_add(unsigned* p, unsigned v) { return __hip_atomic_fetch_add(p, v, __ATOMIC_RELAXED, __HIP_MEMORY_SCOPE_AGENT); }
__device__ __forceinline__ unsigned xb_xcc_id() { return (unsigned)__builtin_amdgcn_s_getreg((3 << 11) | 20) & 0xFu; }
#define XB_SPIN(cond, bar) do { unsigned _sp = 0; while (cond) { __builtin_amdgcn_s_sleep(1); \
    if ((++_sp & 255u) == 0u) { if (xb_ld(&(bar)[XB_TMO])) break; if (_sp > XB_SPIN_CAP) { atomicAdd(&(bar)[XB_TMO], 1u); break; } } } } while (0)

struct XcdBarrier {
    unsigned* bar; unsigned x;
    volatile LAS unsigned* st;
};

__device__ __forceinline__ XcdBarrier xcd_barrier_post(unsigned* bar, volatile LAS unsigned* st) {
    XcdBarrier b; b.bar = bar; b.x = xb_xcc_id(); b.st = st;
    if (threadIdx.x == 0) (void)xb_add(&bar[XB_XCNT(b.x)], 1u);
    return b;
}
__device__ __forceinline__ void xcd_barrier_complete(unsigned* bar, unsigned x, unsigned& nloc, unsigned& nx) {
    const unsigned G = gridDim.x * gridDim.y * gridDim.z;
    unsigned sum, cnt, mine, sp = 0u;
    for (;;) {
        sum = 0u; cnt = 0u; mine = 0u;
#pragma unroll
        for (unsigned j = 0; j < 16; ++j) { const unsigned c = xb_ld(&bar[XB_XCNT(j)]); sum += c; cnt += (c > 0u) ? 1u : 0u; mine = (j == x) ? c : mine; }
        if (sum == G) break;
        __builtin_amdgcn_s_sleep(1);
        if ((++sp & 255u) == 0u) { if (xb_ld(&bar[XB_TMO])) break; if (sp > XB_SPIN_CAP) { atomicAdd(&bar[XB_TMO], 1u); break; } }
    }
    nloc = mine > 0u ? mine : 1u; nx = cnt > 0u ? cnt : 1u;
}

__device__ __forceinline__ void xcd_barrier(const XcdBarrier& b) {
    asm volatile("s_waitcnt vmcnt(0)" ::: "memory");
    __syncthreads();
    if (threadIdx.x == 0) {
        unsigned* bar = b.bar;
        __builtin_amdgcn_s_waitcnt(0);
        unsigned nloc = b.st[0], nx = b.st[1];
        if (nloc == 0u) { xcd_barrier_complete(bar, b.x, nloc, nx); b.st[0] = nloc; b.st[1] = nx; }
        const unsigned old = xb_add(&bar[XB_XSUB(b.x)], 1u);
        const unsigned gen = old / nloc;
        if (old + 1u == (gen + 1u) * nloc) {
            __builtin_amdgcn_fence(__ATOMIC_RELEASE, "agent");
            asm volatile("s_waitcnt vmcnt(0)" ::: "memory");
            const unsigned og = xb_add(&bar[XB_TOP], 1u);
            const unsigned tg = og / nx;
            if (og + 1u == (tg + 1u) * nx) xb_add(&bar[XB_TOPGEN], 1u);
            else XB_SPIN(xb_ld(&bar[XB_TOPGEN]) == tg, bar);
            __builtin_amdgcn_fence(__ATOMIC_ACQUIRE, "agent");
            xb_add(&bar[XB_XGEN(b.x)], 1u);
            asm volatile("s_waitcnt vmcnt(0)" ::: "memory");
        } else {
            XB_SPIN(xb_ld(&bar[XB_XGEN(b.x)]) == gen, bar);
            __builtin_amdgcn_fence(__ATOMIC_ACQUIRE, "agent");
            asm volatile("s_waitcnt vmcnt(0)" ::: "memory");
        }
    }
    __syncthreads();
}

constexpr int D = 1024, BATCH = 4, SEQ = 8192, NMETA = 16, LSEQ = SEQ + NMETA;
constexpr int T = BATCH * SEQ;
constexpr int NP = 2048, NQ = 2048, NEXP = 16384;
constexpr float EPS = 1e-6f;
constexpr int NWAVES = 8;

constexpr size_t MiB = 1u << 20;
constexpr size_t WS_CTL = 0, CTL_ZERO_BYTES = 1 * MiB;
constexpr int CW_BAR = 4096, CW_XS = 8192;
constexpr size_t WS_ROWSS = 512 * 1024;
constexpr size_t WS_WIN = 2 * MiB, WS_WOUT = 6 * MiB, WS_WQ = 8 * MiB, WS_KEYS = 12 * MiB, WS_RSTD1 = 13 * MiB;
constexpr size_t WS_UB = 16 * MiB  , WS_VB = 48 * MiB  , WS_XB = 80 * MiB  , WS_P = 144 * MiB  ;
constexpr size_t WS_H2B = 274 * MiB, WS_SELI = 338 * MiB, WS_SELG = 354 * MiB, WS_END = 370 * MiB;

constexpr int RING_BYTES = 131072, MISC_OFF = RING_BYTES + 320, LDS_BYTES = 147456;

typedef unsigned short bf16;
typedef unsigned v4u __attribute__((ext_vector_type(4)));
typedef unsigned v2u __attribute__((ext_vector_type(2)));
typedef float f32x4 __attribute__((ext_vector_type(4)));
typedef float f32x16 __attribute__((ext_vector_type(16)));
typedef short bf16x8 __attribute__((ext_vector_type(8)));
typedef __bf16 bf16x2_t __attribute__((ext_vector_type(2)));
#define LDS_WAIT() asm volatile("s_waitcnt lgkmcnt(0)" ::: "memory")

__device__ __forceinline__ unsigned f2bf(float f) { unsigned u = __builtin_bit_cast(unsigned, f); return (u + 0x7fffu + ((u >> 16) & 1u)) >> 16; }
__device__ __forceinline__ unsigned pk2(float lo, float hi) { return f2bf(lo) | (f2bf(hi) << 16); }
__device__ __forceinline__ float bflo(unsigned w) { return __builtin_bit_cast(float, w << 16); }
__device__ __forceinline__ float bfhi(unsigned w) { return __builtin_bit_cast(float, w & 0xffff0000u); }
__device__ __forceinline__ float wave_sum(float v) {
#pragma unroll
    for (int o = 1; o < 64; o <<= 1) v += __shfl_xor(v, o);
    return v;
}

struct EpiP {
    static constexpr bool PERM = true, AFTER_DRAIN = false;
    bf16* P; const float* rstd;
    __device__ __forceinline__ void operator()(const pg8::f32x4 (&acc)[2][2][4][2], const pg8::Unit& u, int wr, int wc, int fr, int fq) const {
        const int row0 = u.pm * 256 + wr * 64 + fr, col0 = u.pn * 256 + wc * 32 + 8 * fq;
#pragma unroll
        for (int ai = 0; ai < 2; ++ai)
#pragma unroll
            for (int m = 0; m < 4; ++m) {
                const int row = row0 + ai * 128 + m * 16; const float rs = rstd[row];
                bf16* rowp = P + ((size_t)(row >> 13) * LSEQ + NMETA + (row & 8191)) * NP + col0;
#pragma unroll
                for (int bj = 0; bj < 2; ++bj) { const pg8::f32x4 v0 = acc[ai][bj][m][0] * rs, v1 = acc[ai][bj][m][1] * rs;
                    v4u w; w.x = pg8::cvt_pk_bf16(v0[0], v0[1]); w.y = pg8::cvt_pk_bf16(v0[2], v0[3]); w.z = pg8::cvt_pk_bf16(v1[0], v1[1]); w.w = pg8::cvt_pk_bf16(v1[2], v1[3]);
                    *(v4u*)(rowp + bj * 128) = w; }
            }
    }
};
struct EpiH2 {
    static constexpr bool PERM = true, AFTER_DRAIN = false;
    const float* X; float* H2; bf16* H2B; float* rowss;
    __device__ __forceinline__ void operator()(const pg8::f32x4 (&acc)[2][2][4][2], const pg8::Unit& u, int wr, int wc, int fr, int fq) const {
        const int row0 = u.pm * 256 + wr * 64 + fr, col0 = u.pn * 256 + wc * 32 + 8 * fq;
#pragma unroll
        for (int ai = 0; ai < 2; ++ai)
#pragma unroll
            for (int m = 0; m < 4; ++m) {
                const int row = row0 + ai * 128 + m * 16; const size_t off = (size_t)row * D + col0; float ss = 0.f;
#pragma unroll
                for (int bj = 0; bj < 2; ++bj) {
                    const pg8::f32x4 x0 = *(const pg8::f32x4*)(X + off + bj * 128), x1 = *(const pg8::f32x4*)(X + off + bj * 128 + 4);
                    const pg8::f32x4 v0 = acc[ai][bj][m][0] + x0, v1 = acc[ai][bj][m][1] + x1;
                    *(pg8::f32x4*)(H2 + off + bj * 128) = v0; *(pg8::f32x4*)(H2 + off + bj * 128 + 4) = v1;
                    v4u w; w.x = pg8::cvt_pk_bf16(v0[0], v0[1]); w.y = pg8::cvt_pk_bf16(v0[2], v0[3]); w.z = pg8::cvt_pk_bf16(v1[0], v1[1]); w.w = pg8::cvt_pk_bf16(v1[2], v1[3]);
                    *(v4u*)(H2B + off + bj * 128) = w;
                    ss += (v0[0] * v0[0] + v0[1] * v0[1]) + (v0[2] * v0[2] + v0[3] * v0[3]) + (v1[0] * v1[0] + v1[1] * v1[1]) + (v1[2] * v1[2] + v1[3] * v1[3]);
                }
                ss += __shfl_xor(ss, 16); ss += __shfl_xor(ss, 32);
                if (fq == 0) atomicAdd(rowss + row, ss);
            }
    }
};
struct EpiQ {
    static constexpr bool PERM = true, AFTER_DRAIN = false;
    bf16* Q; const float* rowss;
    __device__ __forceinline__ void operator()(const pg8::f32x4 (&acc)[2][2][4][2], const pg8::Unit& u, int wr, int wc, int fr, int fq) const {
        const int row0 = u.pm * 256 + wr * 64 + fr, col0 = u.pn * 256 + wc * 32 + 8 * fq;
#pragma unroll
        for (int ai = 0; ai < 2; ++ai)
#pragma unroll
            for (int m = 0; m < 4; ++m) {
                const int row = row0 + ai * 128 + m * 16; const float rs = rsqrtf(rowss[row] * (1.0f / D) + EPS);
                bf16* rowp = Q + (size_t)row * NQ + col0;
#pragma unroll
                for (int bj = 0; bj < 2; ++bj) { const pg8::f32x4 v0 = acc[ai][bj][m][0] * rs, v1 = acc[ai][bj][m][1] * rs;
                    v4u w; w.x = pg8::cvt_pk_bf16(v0[0], v0[1]); w.y = pg8::cvt_pk_bf16(v0[2], v0[3]); w.z = pg8::cvt_pk_bf16(v1[0], v1[1]); w.w = pg8::cvt_pk_bf16(v1[2], v1[3]);
                    *(v4u*)(rowp + bj * 128) = w; }
            }
    }
};

__device__ __forceinline__ void row_to_bf16(const float* src, bf16* dst, const float* gain, float* rstd_out, int lane) {
    const f32x4* xr = (const f32x4*)src + lane;
    f32x4 v[4]; float s = 0.f;
#pragma unroll
    for (int j = 0; j < 4; ++j) { v[j] = xr[64 * j]; s += (v[j].x * v[j].x + v[j].y * v[j].y) + (v[j].z * v[j].z + v[j].w * v[j].w); }
    if (rstd_out) { s = wave_sum(s); if (lane == 0) *rstd_out = rsqrtf(s * (1.0f / D) + EPS); }
    if (gain) {
#pragma unroll
        for (int j = 0; j < 4; ++j) v[j] = v[j] * ((const f32x4*)gain)[lane + 64 * j];
    }
    unsigned long long* o8 = (unsigned long long*)dst + lane;
#pragma unroll
    for (int j = 0; j < 4; ++j) o8[64 * j] = (unsigned long long)pk2(v[j].x, v[j].y) | ((unsigned long long)pk2(v[j].z, v[j].w) << 32);
}
typedef float f32x2 __attribute__((ext_vector_type(2)));
constexpr float U8_SCALE = 64.0f, V8_SCALE = 8.0f;
__device__ __forceinline__ void row_to_fp8(const float* src, unsigned char* dst, const float* gain, float scale, int lane) {
    const f32x4* xr = (const f32x4*)src + lane;
    unsigned* o = (unsigned*)dst + lane;
#pragma unroll
    for (int j = 0; j < 4; ++j) { f32x4 v = xr[64 * j]; if (gain) v = v * ((const f32x4*)gain)[lane + 64 * j]; v = v * scale;
        int pk = 0; pk = __builtin_amdgcn_cvt_pk_fp8_f32(v.x, v.y, pk, false); pk = __builtin_amdgcn_cvt_pk_fp8_f32(v.z, v.w, pk, true);
        o[64 * j] = (unsigned)pk; }
}
__device__ __forceinline__ void p0_transpose_item(const float* W, int K, int N, const float* gain, bf16* WT, LAS float* scr, int item, int lane) {
    const int nblk = N / 32, kb = item / nblk, nb = item % nblk, k0 = 64 * kb, n0 = 32 * nb;
#pragma unroll 8
    for (int i = 0; i < 32; ++i) { const int kk = 2 * i + (lane >> 5); const float gk = gain ? gain[k0 + kk] : 1.0f; scr[kk * 33 + (lane & 31)] = W[(size_t)(k0 + kk) * N + n0 + (lane & 31)] * gk; }
    LDS_WAIT(); asm volatile("" ::: "memory");
    const int c = lane & 7;
#pragma unroll
    for (int j = 0; j < 4; ++j) { const int n = (lane >> 3) + 8 * j; const LAS float* s = scr + (8 * c) * 33 + n;
        v4u o; o.x = pk2(s[0 * 33], s[1 * 33]); o.y = pk2(s[2 * 33], s[3 * 33]); o.z = pk2(s[4 * 33], s[5 * 33]); o.w = pk2(s[6 * 33], s[7 * 33]);
        *(v4u*)(WT + (size_t)(n0 + n) * K + k0 + 8 * c) = o; }
    LDS_WAIT(); asm volatile("" ::: "memory");
}
__device__ __forceinline__ void p0_weff_item(const float* w_out, const float* pool_w, const float* pool_scale, bf16* WoutT, int item, int lane) {
    const int nb = item & 15, cg = (item >> 4) & 15, g = item >> 8;
    const int n = nb * 64 + lane;
    float acc[8];
#pragma unroll
    for (int i = 0; i < 8; ++i) acc[i] = 0.f;
    const float* wo = w_out + (size_t)(512 + g * 128) * D + n;
    const float* pw = pool_w + (size_t)(g * 128 + cg * 8) * 128;
    const float* ps = pool_scale + g * 128;
#pragma unroll 4
    for (int d = 0; d < 128; ++d) { const float w = wo[(size_t)d * D] * ps[d];
#pragma unroll
        for (int i = 0; i < 8; ++i) acc[i] += pw[i * 128 + d] * w; }
    v4u o; o.x = pk2(acc[0], acc[1]); o.y = pk2(acc[2], acc[3]); o.z = pk2(acc[4], acc[5]); o.w = pk2(acc[6], acc[7]);
    *(v4u*)(WoutT + (size_t)n * D + 512 + g * 128 + cg * 8) = o;
}
__device__ __forceinline__ void p0_meta(const float* meta, const float* g1, const float* w_in, bf16* P, LAS unsigned char* lds, int blk, int tid) {
    LAS float* mg = (LAS float*)lds;
    LAS float* part = (LAS float*)(lds + 65536);
    LAS float* rs = (LAS float*)(lds + 65536 + 32768);
    const int wave = tid >> 6, lane = tid & 63;
    for (int i = tid; i < 16 * 1024; i += 512) mg[i] = meta[i] * g1[i & 1023];
#pragma unroll
    for (int jj = 0; jj < 2; ++jj) { const int j = wave * 2 + jj; float s = 0.f;
        for (int k = lane; k < 1024; k += 64) { const float v = meta[j * 1024 + k]; s += v * v; }
        s = wave_sum(s); if (lane == 0) rs[j] = rsqrtf(s * (1.0f / D) + EPS); }
    __syncthreads();
    const int nn = tid & 7, kq = tid >> 3;
    float acc[16];
#pragma unroll
    for (int j = 0; j < 16; ++j) acc[j] = 0.f;
#pragma unroll 4
    for (int kk = 0; kk < 16; ++kk) { const int k = 16 * kq + kk; const float w = w_in[(size_t)k * NP + 8 * blk + nn];
#pragma unroll
        for (int j = 0; j < 16; ++j) acc[j] += mg[j * 1024 + k] * w; }
#pragma unroll
    for (int j = 0; j < 16; ++j) part[(kq * 16 + j) * 8 + nn] = acc[j];
    __syncthreads();
    if (tid < 128) { const int j = tid >> 3; float s = 0.f;
        for (int q = 0; q < 64; ++q) s += part[(q * 16 + j) * 8 + nn];
        const bf16 o = (bf16)f2bf(s * rs[j]);
#pragma unroll
        for (int b = 0; b < BATCH; ++b) P[((size_t)b * LSEQ + j) * NP + 8 * blk + nn] = o; }
    __syncthreads();
}

__device__ __forceinline__ void ld8(const bf16* p, float (&f)[8]) {
    const v4u w = *(const v4u*)p;
    f[0] = bflo(w.x); f[1] = bfhi(w.x); f[2] = bflo(w.y); f[3] = bfhi(w.y); f[4] = bflo(w.z); f[5] = bfhi(w.z); f[6] = bflo(w.w); f[7] = bfhi(w.w);
}
__device__ __forceinline__ void st8(bf16* p, const float (&f)[8]) {
    v4u o; o.x = pk2(f[0], f[1]); o.y = pk2(f[2], f[3]); o.z = pk2(f[4], f[5]); o.w = pk2(f[6], f[7]); *(v4u*)p = o;
}
__device__ __forceinline__ void p2_convpool(const bf16* P, const float* conv_w, const float* conv_b, bf16* Y, int blk, int tid) {
    const int cgp = tid & 127, run = tid >> 7;
    const int r_start = blk * 128 + run * 32;
    const int b = r_start >> 13, l0 = NMETA + (r_start & 8191);
    const bf16* Pb = P + (size_t)b * LSEQ * NP;
    if (cgp < 64) {
        const int c0 = cgp * 8;
        float w0[8], w1[8], w2[8], cb[8];
#pragma unroll
        for (int i = 0; i < 8; ++i) { w0[i] = conv_w[c0 + i]; w1[i] = conv_w[512 + c0 + i]; w2[i] = conv_w[1024 + c0 + i]; cb[i] = conv_b[c0 + i]; }
        float zp[8], zc[8], zn[8], a[8], c[8], bg[8], y[8];
        ld8(Pb + (size_t)(l0 - 1) * NP + c0, a); ld8(Pb + (size_t)(l0 - 1) * NP + 1024 + c0, c);
#pragma unroll
        for (int i = 0; i < 8; ++i) zp[i] = a[i] * c[i];
        ld8(Pb + (size_t)l0 * NP + c0, a); ld8(Pb + (size_t)l0 * NP + 1024 + c0, c);
#pragma unroll
        for (int i = 0; i < 8; ++i) zc[i] = a[i] * c[i];
        for (int t = 0; t < 32; ++t) { const int l = l0 + t;
            if (l + 1 < LSEQ) { ld8(Pb + (size_t)(l + 1) * NP + c0, a); ld8(Pb + (size_t)(l + 1) * NP + 1024 + c0, c);
#pragma unroll
                for (int i = 0; i < 8; ++i) zn[i] = a[i] * c[i]; }
            else {
#pragma unroll
                for (int i = 0; i < 8; ++i) zn[i] = 0.f; }
            ld8(Pb + (size_t)l * NP + 512 + c0, bg);
#pragma unroll
            for (int i = 0; i < 8; ++i) { y[i] = bg[i] * (w0[i] * zp[i] + w1[i] * zc[i] + w2[i] * zn[i] + cb[i]); zp[i] = zc[i]; zc[i] = zn[i]; }
            st8(Y + (size_t)(r_start + t) * D + c0, y); }
    } else {
        const int c0 = (cgp - 64) * 8, g = c0 >> 7, hw = 1 << g;
        const bf16* Hb = Pb + 1536 + c0;
        float S[8], v[8], m[8];
#pragma unroll
        for (int i = 0; i < 8; ++i) S[i] = 0.f;
        { const int hi0 = (l0 + hw < LSEQ) ? l0 + hw : LSEQ;
          for (int j = l0 - hw; j < hi0; ++j) { ld8(Hb + (size_t)j * NP, v);
#pragma unroll
              for (int i = 0; i < 8; ++i) S[i] += v[i]; } }
        for (int t = 0; t < 32; ++t) { const int l = l0 + t; const int hi = (l + hw < LSEQ) ? l + hw : LSEQ; const float inv = 1.0f / (float)(hi - (l - hw));
            ld8(Hb + (size_t)l * NP, v);
#pragma unroll
            for (int i = 0; i < 8; ++i) m[i] = S[i] * inv - v[i];
            st8(Y + (size_t)(r_start + t) * D + 512 + c0, m);
            ld8(Hb + (size_t)(l - hw) * NP, v);
#pragma unroll
            for (int i = 0; i < 8; ++i) S[i] -= v[i];
            if (l + hw < LSEQ) { ld8(Hb + (size_t)(l + hw) * NP, v);
#pragma unroll
                for (int i = 0; i < 8; ++i) S[i] += v[i]; } }
    }
}

#define MFMA32(a, b, c) __builtin_amdgcn_mfma_f32_32x32x16_bf16((a), (b), (c), 0, 0, 0)
__device__ __forceinline__ float mkcand(float a, float b, unsigned tag) { return __builtin_bit_cast(float, (__builtin_bit_cast(unsigned, a + b) & ~0xFFu) | tag); }
__device__ __forceinline__ unsigned keylook(unsigned long long lo, unsigned long long hi, unsigned i) {
    const unsigned long long w = (i < 8u) ? lo : hi;
    return (unsigned)(w >> (8u * (i & 7u))) & 127u;
}
__device__ __forceinline__ void p5_item(const bf16* Q, const bf16* KB, int* SI, float* SG, int tg, int head, int lane) {
    const int r = lane & 31, h = lane >> 5;
    const int tok = tg * 32 + r;
    const float NEG = -__builtin_inff();
    float sv[2][16];
#pragma unroll
    for (int p = 0; p < 2; ++p) {
        const int hp = head * 2 + p;
        f32x16 acc[4];
#pragma unroll
        for (int kt = 0; kt < 4; ++kt)
#pragma unroll
            for (int i = 0; i < 16; ++i) acc[kt][i] = 0.f;
        const bf16* qrow = Q + (size_t)tok * NQ + hp * 128 + 8 * h;
        const bf16* kb = KB + ((size_t)hp * 128 + r) * 128 + 8 * h;
#pragma unroll 2
        for (int s = 0; s < 8; ++s) {
            const bf16x8 bq = *(const bf16x8*)(qrow + 16 * s);
#pragma unroll
            for (int kt = 0; kt < 4; ++kt) { const bf16x8 ak = *(const bf16x8*)(kb + (size_t)kt * 32 * 128 + 16 * s); acc[kt] = MFMA32(ak, bq, acc[kt]); }
        }
        __builtin_amdgcn_sched_barrier(0);
        float v[64];
#pragma unroll
        for (int kt = 0; kt < 4; ++kt)
#pragma unroll
            for (int i = 0; i < 16; ++i) { const unsigned key = 32u * kt + (i & 3) + 8u * (i >> 2) + 4u * h;
                const float av = acc[kt][i];
                v[kt * 16 + i] = __builtin_bit_cast(float, (__builtin_bit_cast(unsigned, av) & ~127u) | key); }
#pragma unroll
        for (int t = 0; t < 16; ++t) {
            float m = v[0];
#pragma unroll
            for (int i = 1; i < 64; ++i) m = fmaxf(m, v[i]);
            m = fmaxf(m, __shfl_xor(m, 32));
            sv[p][t] = m;
            const unsigned mb = __builtin_bit_cast(unsigned, m);
#pragma unroll
            for (int i = 0; i < 64; ++i) v[i] = (__builtin_bit_cast(unsigned, v[i]) == mb) ? NEG : v[i];
        }
        __builtin_amdgcn_sched_barrier(0);
    }
    float cv[50];
#define P5_CROW(I, NJ, BASE) _Pragma("unroll") for (int j = 0; j < NJ; ++j) cv[BASE + j] = mkcand(sv[0][I], sv[1][j], (unsigned)((I << 4) | j));
    P5_CROW(0, 16, 0) P5_CROW(1, 8, 16) P5_CROW(2, 5, 24) P5_CROW(3, 4, 29) P5_CROW(4, 3, 33) P5_CROW(5, 2, 36) P5_CROW(6, 2, 38) P5_CROW(7, 2, 40)
    P5_CROW(8, 1, 42) P5_CROW(9, 1, 43) P5_CROW(10, 1, 44) P5_CROW(11, 1, 45) P5_CROW(12, 1, 46) P5_CROW(13, 1, 47) P5_CROW(14, 1, 48) P5_CROW(15, 1, 49)
#undef P5_CROW
    unsigned long long K0lo = 0ull, K0hi = 0ull, K1lo = 0ull, K1hi = 0ull;
#pragma unroll
    for (int i = 0; i < 8; ++i) {
        K0lo |= (unsigned long long)(__builtin_bit_cast(unsigned, sv[0][i]) & 127u) << (8 * i); K0hi |= (unsigned long long)(__builtin_bit_cast(unsigned, sv[0][8 + i]) & 127u) << (8 * i);
        K1lo |= (unsigned long long)(__builtin_bit_cast(unsigned, sv[1][i]) & 127u) << (8 * i); K1hi |= (unsigned long long)(__builtin_bit_cast(unsigned, sv[1][8 + i]) & 127u) << (8 * i); }
    float sel[16];
#pragma unroll
    for (int t = 0; t < 16; ++t) {
        float m = cv[0];
#pragma unroll
        for (int i = 1; i < 50; ++i) m = fmaxf(m, cv[i]);
        sel[t] = m;
        const unsigned mb = __builtin_bit_cast(unsigned, m);
#pragma unroll
        for (int i = 0; i < 50; ++i) cv[i] = (__builtin_bit_cast(unsigned, cv[i]) == mb) ? NEG : cv[i];
    }
    float e[16], esum = 0.f; int eidx[16];
#pragma unroll
    for (int t = 0; t < 16; ++t) { e[t] = __expf(sel[t] - sel[0]); esum += e[t];
        const unsigned tag = __builtin_bit_cast(unsigned, sel[t]) & 0xFFu;
        eidx[t] = (int)(keylook(K0lo, K0hi, tag >> 4) * 128u + keylook(K1lo, K1hi, tag & 15u)); }
    const float inv = 1.0f / esum;
    if (h == 0) { int* o = SI + (size_t)tok * 128 + head * 16;
#pragma unroll
        for (int t = 0; t < 16; t += 4) *(int4*)(o + t) = make_int4(eidx[t], eidx[t + 1], eidx[t + 2], eidx[t + 3]); }
    else { float* o = SG + (size_t)tok * 128 + head * 16;
#pragma unroll
        for (int t = 0; t < 16; t += 4) *(f32x4*)(o + t) = (f32x4){e[t] * inv, e[t + 1] * inv, e[t + 2] * inv, e[t + 3] * inv}; }
}


__device__ __forceinline__ float wave_max(float v) {
#pragma unroll
    for (int o = 1; o < 64; o <<= 1) v = fmaxf(v, __shfl_xor(v, o));
    return v;
}
__device__ __forceinline__ float pick4(float a, float b, float c, float d, int k) { return (k < 2) ? ((k == 0) ? a : b) : ((k == 2) ? c : d); }
__device__ __forceinline__ void p5_simple(const bf16* Q, const bf16* KB, int* SI, float* SG, int tok, int head, int lane) {
    const float NEG = -__builtin_inff();
    float s[2][2];
#pragma unroll
    for (int p = 0; p < 2; ++p) { const int hp = head * 2 + p; const bf16* qrow = Q + (size_t)tok * NQ + hp * 128;
#pragma unroll
        for (int kk = 0; kk < 2; ++kk) { const unsigned key = lane + 64 * kk; const bf16* kr = KB + ((size_t)hp * 128 + key) * 128; float acc = 0.f;
            for (int d = 0; d < 128; d += 8) { float qf[8], kf[8]; ld8(qrow + d, qf); ld8(kr + d, kf);
#pragma unroll
                for (int i = 0; i < 8; ++i) acc += qf[i] * kf[i]; }
            s[p][kk] = __builtin_bit_cast(float, (__builtin_bit_cast(unsigned, acc) & ~127u) | key); } }
    float sv[2][16];
#pragma unroll
    for (int p = 0; p < 2; ++p)
#pragma unroll
        for (int t = 0; t < 16; ++t) { const float m = wave_max(fmaxf(s[p][0], s[p][1])); sv[p][t] = m; const unsigned mb = __builtin_bit_cast(unsigned, m);
            s[p][0] = (__builtin_bit_cast(unsigned, s[p][0]) == mb) ? NEG : s[p][0]; s[p][1] = (__builtin_bit_cast(unsigned, s[p][1]) == mb) ? NEG : s[p][1]; }
    const int j = lane & 15, ib = lane >> 4;
    float s1j = sv[1][0];
#pragma unroll
    for (int jj = 1; jj < 16; ++jj) s1j = (j == jj) ? sv[1][jj] : s1j;
    float cv[4];
#pragma unroll
    for (int q = 0; q < 4; ++q) { const float s0i = pick4(sv[0][4 * q], sv[0][4 * q + 1], sv[0][4 * q + 2], sv[0][4 * q + 3], ib);
        cv[q] = mkcand(s0i, s1j, (unsigned)(((4 * q + ib) << 4) | j)); }
    unsigned long long K0lo = 0ull, K0hi = 0ull, K1lo = 0ull, K1hi = 0ull;
#pragma unroll
    for (int i = 0; i < 8; ++i) {
        K0lo |= (unsigned long long)(__builtin_bit_cast(unsigned, sv[0][i]) & 127u) << (8 * i); K0hi |= (unsigned long long)(__builtin_bit_cast(unsigned, sv[0][8 + i]) & 127u) << (8 * i);
        K1lo |= (unsigned long long)(__builtin_bit_cast(unsigned, sv[1][i]) & 127u) << (8 * i); K1hi |= (unsigned long long)(__builtin_bit_cast(unsigned, sv[1][8 + i]) & 127u) << (8 * i); }
    float sel[16];
#pragma unroll
    for (int t = 0; t < 16; ++t) { const float m = wave_max(fmaxf(fmaxf(cv[0], cv[1]), fmaxf(cv[2], cv[3]))); sel[t] = m; const unsigned mb = __builtin_bit_cast(unsigned, m);
#pragma unroll
        for (int q = 0; q < 4; ++q) cv[q] = (__builtin_bit_cast(unsigned, cv[q]) == mb) ? NEG : cv[q]; }
    float e[16], esum = 0.f; int eidx[16];
#pragma unroll
    for (int t = 0; t < 16; ++t) { e[t] = __expf(sel[t] - sel[0]); esum += e[t];
        const unsigned tag = __builtin_bit_cast(unsigned, sel[t]) & 0xFFu;
        eidx[t] = (int)(keylook(K0lo, K0hi, tag >> 4) * 128u + keylook(K1lo, K1hi, tag & 15u)); }
    const float inv = 1.0f / esum;
    if (lane == 0) { int* o = SI + (size_t)tok * 128 + head * 16; float* og = SG + (size_t)tok * 128 + head * 16;
#pragma unroll
        for (int t = 0; t < 16; ++t) { o[t] = eidx[t]; og[t] = e[t] * inv; } }
}

__device__ __forceinline__ f32x2 cvt8(unsigned w, bool hi) { return hi ? __builtin_amdgcn_cvt_pk_f32_fp8((int)w, true) : __builtin_amdgcn_cvt_pk_f32_fp8((int)w, false); }
__device__ __forceinline__ void sort128(unsigned& k0, unsigned& k1, int lane) {
#pragma unroll
    for (int k = 1; k <= 7; ++k)
#pragma unroll
        for (int j = k - 1; j >= 0; --j) {
            if (j == 6) { const unsigned lo = k0 < k1 ? k0 : k1, hi = k0 < k1 ? k1 : k0; k0 = lo; k1 = hi; }
            else {
                const unsigned o0 = (unsigned)__shfl_xor((int)k0, 1 << j), o1 = (unsigned)__shfl_xor((int)k1, 1 << j);
                const bool lower = ((lane >> j) & 1) == 0;
                const bool up0 = (k == 7) ? true : ((k == 6) ? true : (((lane >> k) & 1) == 0));
                const bool up1 = (k == 7) ? true : ((k == 6) ? false : (((lane >> k) & 1) == 0));
                const unsigned mn0 = k0 < o0 ? k0 : o0, mx0 = k0 < o0 ? o0 : k0, mn1 = k1 < o1 ? k1 : o1, mx1 = k1 < o1 ? o1 : k1;
                k0 = (lower == up0) ? mn0 : mx0; k1 = (lower == up1) ? mn1 : mx1;
            }
        }
}
__device__ __forceinline__ void xcd_align(unsigned* cnt, unsigned nloc, unsigned& epoch) {
    __syncthreads();
    ++epoch;
    if (threadIdx.x == 0) {
        __hip_atomic_fetch_add(cnt, 1u, __ATOMIC_RELAXED, __HIP_MEMORY_SCOPE_AGENT);
        const unsigned target = nloc * epoch; unsigned sp = 0;
        while (__hip_atomic_load(cnt, __ATOMIC_RELAXED, __HIP_MEMORY_SCOPE_AGENT) < target && ++sp < (1u << 14)) __builtin_amdgcn_s_sleep(2);
    }
    __syncthreads();
}
constexpr int P6K = 4;
#define P6_ROWLOAD(TAB, J, B) do { _Pragma("unroll") for (int k = 0; k < 4; ++k) { const int e_ = 4 * (B) + k; \
        const int idx_ = __builtin_amdgcn_readlane(((B) < 16) ? idx0[J] : idx1[J], e_ & 63); \
        rows[J][k] = ((const v4u*)((TAB) + (size_t)idx_ * D))[lane]; } } while (0)
__device__ __forceinline__ void p6_round(const bf16* H2B, const float* rowss, const int* SI, const float* SG, const unsigned char* U8, const unsigned char* V8, const float* gf, float* OUT,
                                         int tok0, int lane, unsigned* xcnt, unsigned nloc, unsigned& epoch) {
    unsigned xw[P6K][8]; int idx0[P6K], idx1[P6K]; float gs0[P6K], gs1[P6K], asc[P6K];
#pragma unroll
    for (int j = 0; j < P6K; ++j) { const int tok = tok0 + j;
        const v4u* hb = (const v4u*)(H2B + (size_t)tok * D) + 2 * lane;
        const v4u xa = hb[0], xb = hb[1];
        xw[j][0] = xa.x; xw[j][1] = xa.y; xw[j][2] = xa.z; xw[j][3] = xa.w; xw[j][4] = xb.x; xw[j][5] = xb.y; xw[j][6] = xb.z; xw[j][7] = xb.w;
        unsigned k0 = ((unsigned)SI[(size_t)tok * 128 + lane] << 7) | (unsigned)lane, k1 = ((unsigned)SI[(size_t)tok * 128 + 64 + lane] << 7) | (unsigned)(64 + lane);
        sort128(k0, k1, lane);
        idx0[j] = (int)(k0 >> 7); idx1[j] = (int)(k1 >> 7);
        gs0[j] = SG[(size_t)tok * 128 + (k0 & 127u)]; gs1[j] = SG[(size_t)tok * 128 + (k1 & 127u)];
        asc[j] = rsqrtf(rowss[tok] * (1.0f / D) + EPS) * (1.0f / U8_SCALE); }
    const bool h5 = (lane & 32) != 0, h4 = (lane & 16) != 0;
    const int kl = ((lane >> 5) & 1) + 2 * ((lane >> 4) & 1);
    const int lh = 32 * (lane & 1) + 16 * ((lane >> 1) & 1);
    float w0[P6K], w1[P6K];
#pragma unroll
    for (int j = 0; j < P6K; ++j) { w0[j] = 0.f; w1[j] = 0.f; }
    v4u rows[P6K][4];
    xcd_align(xcnt, nloc, epoch);
#pragma unroll
    for (int j = 0; j < P6K; ++j) P6_ROWLOAD(U8, j, 0);
    for (int b = 0; b < 32; ++b) {
#pragma unroll
        for (int j = 0; j < P6K; ++j) {
            f32x2 x2[8];
#pragma unroll
            for (int q = 0; q < 8; ++q) { unsigned t_ = xw[j][q]; asm volatile("" : "+v"(t_)); x2[q] = (f32x2){bflo(t_), bfhi(t_)}; }
            float d_[4];
#pragma unroll
            for (int k = 0; k < 4; ++k) { f32x2 a2 = {0.f, 0.f}; const unsigned uw_[4] = {rows[j][k].x, rows[j][k].y, rows[j][k].z, rows[j][k].w};
#pragma unroll
                for (int q = 0; q < 4; ++q) { a2 = cvt8(uw_[q], false) * x2[2 * q] + a2; a2 = cvt8(uw_[q], true) * x2[2 * q + 1] + a2; }
                d_[k] = a2.x + a2.y; }
            if (b + 1 < 32) P6_ROWLOAD(U8, j, b + 1);
            float r_[2];
#pragma unroll
            for (int i = 0; i < 2; ++i) { const float a_ = h5 ? d_[2 * i + 1] : d_[2 * i], b_ = h5 ? d_[2 * i] : d_[2 * i + 1]; r_[i] = a_ + __shfl_xor(b_, 32); }
            float s_; { const float a_ = h4 ? r_[1] : r_[0], b_ = h4 ? r_[0] : r_[1]; s_ = a_ + __shfl_xor(b_, 16); }
            s_ += __shfl_xor(s_, 8); s_ += __shfl_xor(s_, 4); s_ += __shfl_xor(s_, 2); s_ += __shfl_xor(s_, 1);
            const float gl_ = __shfl((b < 16) ? gs0[j] : gs1[j], (4 * b + kl) & 63);
            const float a_ = s_ * asc[j];
            const float wv_ = gl_ * 0.5f * a_ * (1.0f + erff(a_ * 0.70710678118654752f)) * (1.0f / V8_SCALE);
            const float wp_ = __shfl(wv_, lh);
            const bool mine = (lane >> 2) == (b & 15);
            w0[j] = (mine && b < 16) ? wp_ : w0[j]; w1[j] = (mine && b >= 16) ? wp_ : w1[j];
        }
    }
    xcd_align(xcnt, nloc, epoch);
    f32x2 o2[P6K][8];
#pragma unroll
    for (int j = 0; j < P6K; ++j) {
#pragma unroll
        for (int q = 0; q < 8; ++q) o2[j][q] = (f32x2){0.f, 0.f};
        P6_ROWLOAD(V8, j, 0); }
    for (int b = 0; b < 32; ++b) {
#pragma unroll
        for (int j = 0; j < P6K; ++j) {
#pragma unroll
            for (int k = 0; k < 4; ++k) { const float w_ = __builtin_bit_cast(float, __builtin_amdgcn_readlane(__builtin_bit_cast(int, (b < 16) ? w0[j] : w1[j]), (4 * b + k) & 63));
                const unsigned vw_[4] = {rows[j][k].x, rows[j][k].y, rows[j][k].z, rows[j][k].w};
#pragma unroll
                for (int q = 0; q < 4; ++q) { o2[j][2 * q] = cvt8(vw_[q], false) * w_ + o2[j][2 * q]; o2[j][2 * q + 1] = cvt8(vw_[q], true) * w_ + o2[j][2 * q + 1]; } }
            if (b + 1 < 32) P6_ROWLOAD(V8, j, b + 1);
        }
    }
    const f32x4* gp = (const f32x4*)gf + 4 * lane;
#pragma unroll
    for (int j = 0; j < P6K; ++j) {
        f32x4* op = (f32x4*)(OUT + (size_t)(tok0 + j) * D) + 4 * lane;
        f32x4 y[4]; float ss = 0.f;
#pragma unroll
        for (int q = 0; q < 4; ++q) { const f32x4 hv = op[q]; y[q] = (f32x4){hv.x + o2[j][2 * q].x, hv.y + o2[j][2 * q].y, hv.z + o2[j][2 * q + 1].x, hv.w + o2[j][2 * q + 1].y};
            ss += (y[q].x * y[q].x + y[q].y * y[q].y) + (y[q].z * y[q].z + y[q].w * y[q].w); }
        ss = wave_sum(ss);
        const float rs = rsqrtf(ss * (1.0f / D) + EPS);
#pragma unroll
        for (int q = 0; q < 4; ++q) op[q] = y[q] * rs * gp[q];
    }
}

struct Args { const float* in[15]; float* out; unsigned char* ws; int ph_lo, ph_hi; };
constexpr int NPHASE = 7;
#ifndef MK_N_LAUNCHES
#define MK_N_LAUNCHES 1
#endif

__global__ void __launch_bounds__(NWAVES * 64, 2) fwd_kernel(Args args) {
    extern __shared__ __attribute__((aligned(16))) unsigned char lds_raw[];
    LAS unsigned char* lds = (LAS unsigned char*)lds_raw;
    volatile LAS unsigned* MISC = (volatile LAS unsigned*)(lds + MISC_OFF);
    const int tid = threadIdx.x, lane = tid & 63, wave = __builtin_amdgcn_readfirstlane(tid >> 6);
    const int G = gridDim.x, blk = blockIdx.x;
    unsigned char* ws = args.ws;
    const float* x = args.in[0]; const float* meta = args.in[1]; const float* g1 = args.in[2]; const float* w_in = args.in[3];
    const float* conv_w = args.in[4]; const float* conv_b = args.in[5]; const float* pool_w = args.in[6]; const float* pool_scale = args.in[7];
    const float* w_out = args.in[8]; const float* g2 = args.in[9]; const float* w_q = args.in[10]; const float* keys = args.in[11];
    const float* pu = args.in[12]; const float* pv = args.in[13]; const float* gf = args.in[14];
    bf16* WinT = (bf16*)(ws + WS_WIN); bf16* WoutT = (bf16*)(ws + WS_WOUT); bf16* WqT = (bf16*)(ws + WS_WQ); bf16* KB = (bf16*)(ws + WS_KEYS);
    float* rstd1 = (float*)(ws + WS_RSTD1); float* rowss = (float*)(ws + WS_ROWSS);
    unsigned char* U8 = ws + WS_UB; unsigned char* V8 = ws + WS_VB; bf16* XB = (bf16*)(ws + WS_XB); bf16* YP = (bf16*)(ws + WS_XB);
    bf16* P = (bf16*)(ws + WS_P); bf16* Qb = (bf16*)(ws + WS_P); bf16* H2B = (bf16*)(ws + WS_H2B);
    int* SI = (int*)(ws + WS_SELI); float* SG = (float*)(ws + WS_SELG);

    for (int u = tid; u < (LDS_BYTES - RING_BYTES) / 4; u += NWAVES * 64) ((LAS unsigned*)(lds + RING_BYTES))[u] = 0u;
    __syncthreads();
    const int lo = args.ph_lo, hi = args.ph_hi;
    XcdBarrier bar; bar.bar = (unsigned*)(ws + WS_CTL) + CW_BAR; bar.x = 0; bar.st = nullptr;
    if (hi - lo > 1) bar = xcd_barrier_post((unsigned*)(ws + WS_CTL) + CW_BAR, MISC + 8);
#define IN(k) (lo <= (k) && (k) < hi)
#define SEAM(k) do { if (IN(k) && IN((k) + 1)) xcd_barrier(bar); } while (0)
    const int gw = blk * NWAVES + wave, NGW = G * NWAVES;

    if (IN(0)) {
        for (int mb = blk; mb < 256; mb += G) p0_meta(meta, g1, w_in, P, lds, mb, tid);
        LAS float* scr = (LAS float*)(lds + wave * 16384);
        for (int it = gw; it < 1024 + 1024 + 256 + 1024; it += NGW) {
            int r = __builtin_amdgcn_readfirstlane(it);
            if (r < 1024) { p0_transpose_item(w_in, D, NP, g1, WinT, scr, r, lane); continue; } r -= 1024;
            if (r < 1024) { p0_transpose_item(w_q, D, NQ, g2, WqT, scr, r, lane); continue; } r -= 1024;
            if (r < 256) { p0_transpose_item(w_out, D, D, nullptr, WoutT, scr, r, lane); continue; } r -= 256;
            p0_weff_item(w_out, pool_w, pool_scale, WoutT, r, lane);
        }
        for (int m = gw; m < T; m += NGW) row_to_bf16(x + (size_t)m * D, XB + (size_t)m * D, nullptr, rstd1 + m, lane);
        for (int m = gw; m < NEXP; m += NGW) { row_to_fp8(pu + (size_t)m * D, U8 + (size_t)m * D, g2, U8_SCALE, lane); row_to_fp8(pv + (size_t)m * D, V8 + (size_t)m * D, nullptr, V8_SCALE, lane); }
        for (int m = gw; m < 256; m += NGW) row_to_bf16(keys + (size_t)m * D, KB + (size_t)m * D, nullptr, nullptr, lane);
    }
    SEAM(0);
    if (IN(1)) {
        pg8::Gemm g{XB, WinT, T, NP, D}; pg8::StaticOrder S; S.init(T, NP, G, blk);
        EpiP E{P, rstd1};
        pg8::gemm_phase<EpiP, pg8::StaticOrder, true, true>(lds, g, S, E);
    }
    SEAM(1);
    if (IN(2)) {
        for (int b2 = blk; b2 < T / 128; b2 += G) p2_convpool(P, conv_w, conv_b, YP, b2, tid);
    }
    SEAM(2);
    if (IN(3)) {
        pg8::Gemm g{YP, WoutT, T, D, D}; pg8::StaticOrder S; S.init(T, D, G, blk);
        EpiH2 E{x, args.out, H2B, rowss};
        pg8::gemm_phase<EpiH2, pg8::StaticOrder, true, true>(lds, g, S, E);
    }
    SEAM(3);
    if (IN(4)) {
        pg8::Gemm g{H2B, WqT, T, NQ, D}; pg8::StaticOrder S; S.init(T, NQ, G, blk);
        EpiQ E{Qb, rowss};
        pg8::gemm_phase<EpiQ, pg8::StaticOrder, true, true>(lds, g, S, E);
    }
    SEAM(4);
    if (IN(5)) {
#ifdef P5_SIMPLE
        for (int it = gw; it < T * 8; it += NGW) p5_simple(Qb, KB, SI, SG, it >> 3, it & 7, lane);
#else
        for (int it = gw; it < (T / 32) * 8; it += NGW) p5_item(Qb, KB, SI, SG, it >> 3, it & 7, lane);
#endif
    }
    SEAM(5);
    if (IN(6)) {
        unsigned epoch = 0u; const unsigned nloc = MISC[8] ? MISC[8] : (unsigned)(G / 8);
        unsigned* xcnt = (unsigned*)(ws + WS_CTL) + CW_XS + 64 * xb_xcc_id();
        for (int t0 = gw * P6K; t0 < T; t0 += NGW * P6K) p6_round(H2B, rowss, SI, SG, U8, V8, gf, args.out, t0, lane, xcnt, nloc, epoch);
    }
#undef IN
#undef SEAM
}

extern "C" void kernel_launch(void* const* d_in, const int* in_sizes, int n_in, void* d_out, int out_size, void* d_ws, size_t ws_size, hipStream_t stream) {
    static int grid = 0;
    if (grid == 0) {
        if (n_in != 15 || out_size != T * D || ws_size < WS_END) { fprintf(stderr, "kernel_launch: unexpected shapes: n_in %d out %d ws %zu (need %zu)\n", n_in, out_size, ws_size, (size_t)WS_END); grid = -1; return; }
        int dev = 0, cus = 0, per_cu = 0;
        if (hipGetDevice(&dev) != hipSuccess || hipDeviceGetAttribute(&cus, hipDeviceAttributeMultiprocessorCount, dev) != hipSuccess) { grid = -1; return; }
        if (hipFuncSetAttribute((const void*)fwd_kernel, hipFuncAttributeMaxDynamicSharedMemorySize, LDS_BYTES) != hipSuccess) { fprintf(stderr, "kernel_launch: hipFuncSetAttribute failed\n"); grid = -1; return; }
        if (hipOccupancyMaxActiveBlocksPerMultiprocessor(&per_cu, (const void*)fwd_kernel, NWAVES * 64, LDS_BYTES) != hipSuccess || per_cu < 1) fprintf(stderr, "kernel_launch: occupancy query says %d\n", per_cu);
        (void)hipGetLastError();
        grid = cus;
    }
    if (grid < 0) return;
    (void)hipMemsetAsync((char*)d_ws + WS_CTL, 0, CTL_ZERO_BYTES, stream);
    Args a{};
    for (int i = 0; i < 15; ++i) a.in[i] = (const float*)d_in[i];
    a.out = (float*)d_out; a.ws = (unsigned char*)d_ws;
#if MK_N_LAUNCHES == 1
    a.ph_lo = 0; a.ph_hi = NPHASE;
    hipLaunchKernelGGL(fwd_kernel, dim3(grid), dim3(NWAVES * 64), LDS_BYTES, stream, a);
#else
    for (int li = 0; li < NPHASE; ++li) { a.ph_lo = li; a.ph_hi = li + 1;
        hipLaunchKernelGGL(fwd_kernel, dim3(grid), dim3(NWAVES * 64), LDS_BYTES, stream, a); }
#endif
}
```

```cpp
#include <hip/hip_runtime.h>
#include <cstdio>
#include <cstdint>
namespace pg8 {
#define PG8_LAS __attribute__((address_space(3)))
typedef unsigned short bf16_t;
typedef short bf16x8 __attribute__((ext_vector_type(8)));
typedef float f32x4 __attribute__((ext_vector_type(4)));
typedef unsigned u32x4 __attribute__((ext_vector_type(4)));
constexpr int BM = 256, BK = 64, HALF = 128, HTB = HALF * BK * 2  , STAGE_BYTES = 8 * HTB, NXCD = 8, WGM = 8;

__host__ __device__ __forceinline__ int lds_byte(int r, int c) { const int st = (r >> 4) * 2 + (c >> 5), rr = r & 15, cc = c & 31, ob = rr * 64 + cc * 2; return st * 1024 + (ob ^ (((ob >> 9) & 1) << 5)); }
__host__ __device__ __forceinline__ void stage_rc(int b, int& R, int& C) { const int st = b / 1024, sb = b % 1024, swz = sb ^ (((sb >> 9) & 1) << 5); R = (st >> 1) * 16 + swz / 64; C = (st & 1) * 32 + (swz % 64) / 2; }
__host__ __device__ __forceinline__ int perm32(int rho) { const int n = rho >> 4, i = rho & 15; return 8 * (i >> 2) + 4 * n + (i & 3); }

struct Unit { int pm, pn; };
struct Gemm { const bf16_t* A; const bf16_t* Bt; int M, N, K; };

struct StaticOrder {
    int nM, nN, nwg, G, c;
    __host__ __device__ void init(int M, int N, int G_, int c_) { nM = M / BM; nN = N / BM; nwg = nM * nN; G = G_; c = c_; }
    __host__ __device__ bool next(int i, Unit& u) const {
        const long L = (long)i * G + c; if (L >= nwg) return false;
        int wgid = (int)L; { const int q = nwg / NXCD, r = nwg % NXCD, xcd = wgid % NXCD, off = wgid / NXCD; wgid = (xcd < r ? xcd * (q + 1) : r * (q + 1) + (xcd - r) * q) + off; }
        const int nig = WGM * nN, gid = wgid / nig, fm = gid * WGM, gsz = (nM - fm) < WGM ? (nM - fm) : WGM;
        u.pm = fm + ((wgid % nig) % gsz); u.pn = (wgid % nig) / gsz; return true;
    }
    __device__ __forceinline__ void a_ready(const Unit&) const {}
    __device__ __forceinline__ void done(const Unit&) const {}
};

__device__ __forceinline__ unsigned cvt_pk_bf16(float lo, float hi) { unsigned r; asm volatile("v_cvt_pk_bf16_f32 %0, %1, %2" : "=v"(r) : "v"(lo), "v"(hi)); return r; }
template <class Epi, class Sched, bool ALIGN_EPI = false, bool SP2 = false>
__device__ __forceinline__ void gemm_phase(PG8_LAS unsigned char* lds, const Gemm g, const Sched& S, const Epi& E) {
    const int tid = threadIdx.x, wid = __builtin_amdgcn_readfirstlane(tid >> 6), lane = tid & 63, wr = wid >> 2, wc = wid & 3, fr = lane & 15, fq = lane >> 4;
    const int K = g.K, nt = K / BK;
    unsigned voffA[2], voffB[2];
#pragma unroll
    for (int i = 0; i < 2; ++i) { int R, C; stage_rc(tid * 16 + i * 8192, R, C); const int Rb = Epi::PERM ? ((R & ~31) + perm32(R & 31)) : R;
        voffA[i] = (unsigned)(R * K + C) * 2u; voffB[i] = (unsigned)(Rb * K + C) * 2u; }
    const size_t kstep = (size_t)(BK * 2);
    const size_t hstep = (size_t)HALF * K * 2;
    const size_t tstep = 2 * hstep;
    const unsigned ldsw = (unsigned)wid * 1024u;
    const int aoff = lds_byte(wr * 64 + fr, fq * 8), boff = lds_byte(wc * 32 + fr, fq * 8);
#define PG8_SA(b, h) (((b) * 2 + (h)) * HTB)
#define PG8_SB(b, h) ((4 + (b) * 2 + (h)) * HTB)
#define PG8_STAGE(bufoff, gbase, voff) do { _Pragma("unroll") for (int _i = 0; _i < 2; ++_i) \
        __builtin_amdgcn_global_load_lds((const unsigned*)((const char*)(gbase) + (voff)[_i]), (PG8_LAS unsigned*)(lds + (bufoff) + ldsw + _i * 8192), 16, 0, 0); } while (0)
#define PG8_LDA(dst, b, h) do { _Pragma("unroll") for (int m = 0; m < 4; ++m) _Pragma("unroll") for (int k = 0; k < 2; ++k) dst[m][k] = *(const PG8_LAS bf16x8*)(lds + PG8_SA(b, h) + aoff + m * 2048 + k * 1024); } while (0)
#define PG8_LDB(dst, b, h) do { _Pragma("unroll") for (int n = 0; n < 2; ++n) _Pragma("unroll") for (int k = 0; k < 2; ++k) dst[n][k] = *(const PG8_LAS bf16x8*)(lds + PG8_SB(b, h) + boff + n * 2048 + k * 1024); } while (0)
#define PG8_MMA(ai, bj, At, Bt) do { __builtin_amdgcn_s_setprio(1); _Pragma("unroll") for (int m = 0; m < 4; ++m) _Pragma("unroll") for (int n = 0; n < 2; ++n) _Pragma("unroll") for (int k = 0; k < 2; ++k) \
        acc[ai][bj][m][n] = __builtin_amdgcn_mfma_f32_16x16x32_bf16(Bt[n][k], At[m][k], acc[ai][bj][m][n], 0, 0, 0); __builtin_amdgcn_s_setprio(0); } while (0)
#define PG8_WAIT_V(n) asm volatile("s_waitcnt vmcnt(" #n ")" ::: "memory")
#define PG8_WAIT_L(n) asm volatile("s_waitcnt lgkmcnt(" #n ")" ::: "memory")
#define PG8_BAR __builtin_amdgcn_s_barrier()
#define PG8_SCHED __builtin_amdgcn_sched_barrier(0)
    Unit cur, nxt; int ui = 0;
    if (!S.next(0, cur)) return;
    f32x4 acc[2][2][4][2];
#pragma unroll
    for (int a = 0; a < 2; ++a)
#pragma unroll
        for (int b = 0; b < 2; ++b)
#pragma unroll
            for (int m = 0; m < 4; ++m)
#pragma unroll
                for (int n = 0; n < 2; ++n) acc[a][b][m][n] = (f32x4){0.f, 0.f, 0.f, 0.f};
    bf16x8 At[4][2], B0[2][2], B1[2][2];
    const char* cA = (const char*)g.A + (size_t)cur.pm * tstep; const char* cB = (const char*)g.Bt + (size_t)cur.pn * tstep;
    S.a_ready(cur);
    if constexpr (SP2) {
        PG8_STAGE(PG8_SB(0, 0), cB, voffB); PG8_STAGE(PG8_SB(0, 1), cB + hstep, voffB); PG8_STAGE(PG8_SA(0, 0), cA, voffA); PG8_STAGE(PG8_SA(0, 1), cA + hstep, voffA);
        if (wr == 1) PG8_BAR;
        PG8_WAIT_V(2); PG8_BAR;
        PG8_STAGE(PG8_SB(1, 0), cB + kstep, voffB); PG8_STAGE(PG8_SA(1, 0), cA + kstep, voffA); PG8_STAGE(PG8_SB(1, 1), cB + hstep + kstep, voffB);
        PG8_WAIT_V(6); PG8_BAR;
    } else {
        PG8_STAGE(PG8_SB(0, 0), cB, voffB); PG8_STAGE(PG8_SA(0, 0), cA, voffA); PG8_STAGE(PG8_SB(0, 1), cB + hstep, voffB); PG8_STAGE(PG8_SA(0, 1), cA + hstep, voffA);
        if (wr == 1) PG8_BAR;
        PG8_WAIT_V(4); PG8_BAR;
        PG8_STAGE(PG8_SB(1, 0), cB + kstep, voffB); PG8_STAGE(PG8_SA(1, 0), cA + kstep, voffA); PG8_STAGE(PG8_SB(1, 1), cB + hstep + kstep, voffB);
        PG8_WAIT_V(6); PG8_BAR;
    }
    for (;;) {
        const bool has_next = S.next(ui + 1, nxt);
        const char* nA = has_next ? (const char*)g.A + (size_t)nxt.pm * tstep : cA; const char* nB = has_next ? (const char*)g.Bt + (size_t)nxt.pn * tstep : cB;
        for (int t = 0; t < nt; t += 2) {
            const bool last = (t == nt - 2);
            const char* a1 = cA + (size_t)(t + 1) * kstep;
            const char* a2 = last ? nA : cA + (size_t)(t + 2) * kstep; const char* b2 = last ? nB : cB + (size_t)(t + 2) * kstep;
            const char* a3 = a2 + kstep; const char* b3 = b2 + kstep;
            if (last && has_next) S.a_ready(nxt);
            if constexpr (SP2) {
            PG8_LDB(B0, 0, 0); PG8_LDB(B1, 0, 1); PG8_SCHED; PG8_LDA(At, 0, 0); PG8_STAGE(PG8_SA(1, 1), a1 + hstep, voffA);
            PG8_WAIT_V(8); PG8_WAIT_L(0); PG8_BAR; PG8_MMA(0, 0, At, B0); PG8_MMA(0, 1, At, B1); PG8_BAR; PG8_SCHED;
            PG8_LDA(At, 0, 1); PG8_STAGE(PG8_SB(0, 0), b2, voffB); PG8_STAGE(PG8_SB(0, 1), b2 + hstep, voffB); PG8_STAGE(PG8_SA(0, 0), a2, voffA);
            PG8_WAIT_V(8); PG8_WAIT_L(0); PG8_BAR; PG8_MMA(1, 0, At, B0); PG8_MMA(1, 1, At, B1); PG8_BAR; PG8_SCHED;
            PG8_LDB(B0, 1, 0); PG8_LDB(B1, 1, 1); PG8_SCHED; PG8_LDA(At, 1, 0); PG8_STAGE(PG8_SA(0, 1), a2 + hstep, voffA);
            PG8_WAIT_V(8); PG8_WAIT_L(0); PG8_BAR; PG8_MMA(0, 0, At, B0); PG8_MMA(0, 1, At, B1); PG8_BAR; PG8_SCHED;
            PG8_LDA(At, 1, 1); PG8_STAGE(PG8_SB(1, 0), b3, voffB); PG8_STAGE(PG8_SB(1, 1), b3 + hstep, voffB); PG8_STAGE(PG8_SA(1, 0), a3, voffA);
            PG8_WAIT_V(8); PG8_WAIT_L(0); PG8_BAR; PG8_MMA(1, 0, At, B0); PG8_MMA(1, 1, At, B1); PG8_BAR; PG8_SCHED;
            } else {
            PG8_LDB(B0, 0, 0); PG8_SCHED; PG8_LDA(At, 0, 0); PG8_STAGE(PG8_SA(1, 1), a1 + hstep, voffA);
            PG8_WAIT_L(8); PG8_BAR; PG8_WAIT_L(0); PG8_MMA(0, 0, At, B0); PG8_BAR; PG8_SCHED;
            PG8_LDB(B1, 0, 1); PG8_STAGE(PG8_SB(0, 0), b2, voffB);
            PG8_BAR; PG8_WAIT_L(0); PG8_MMA(0, 1, At, B1); PG8_BAR;
            PG8_LDA(At, 0, 1); PG8_STAGE(PG8_SA(0, 0), a2, voffA);
            PG8_BAR; PG8_WAIT_L(0); PG8_MMA(1, 0, At, B0); PG8_BAR; PG8_SCHED;
            PG8_STAGE(PG8_SB(0, 1), b2 + hstep, voffB);
            PG8_WAIT_V(6); PG8_BAR; PG8_MMA(1, 1, At, B1); PG8_BAR;
            PG8_LDB(B0, 1, 0); PG8_SCHED; PG8_LDA(At, 1, 0); PG8_STAGE(PG8_SA(0, 1), a2 + hstep, voffA);
            PG8_WAIT_L(8); PG8_BAR; PG8_WAIT_L(0); PG8_MMA(0, 0, At, B0); PG8_BAR; PG8_SCHED;
            PG8_LDB(B1, 1, 1); PG8_STAGE(PG8_SB(1, 0), b3, voffB);
            PG8_BAR; PG8_WAIT_L(0); PG8_MMA(0, 1, At, B1); PG8_BAR;
            PG8_LDA(At, 1, 1); PG8_STAGE(PG8_SA(1, 0), a3, voffA);
            PG8_BAR; PG8_WAIT_L(0); PG8_MMA(1, 0, At, B0); PG8_BAR; PG8_SCHED;
            PG8_STAGE(PG8_SB(1, 1), b3 + hstep, voffB);
            PG8_WAIT_V(6); PG8_BAR; PG8_MMA(1, 1, At, B1); PG8_BAR;
            }
        }
        if constexpr (ALIGN_EPI) { if (wr == 0) PG8_BAR; }
        if constexpr (!Epi::AFTER_DRAIN) { E(acc, cur, wr, wc, fr, fq); S.done(cur); }
        if (!has_next) break;
#pragma unroll
        for (int a = 0; a < 2; ++a)
#pragma unroll
            for (int b = 0; b < 2; ++b)
#pragma unroll
                for (int m = 0; m < 4; ++m)
#pragma unroll
                    for (int n = 0; n < 2; ++n) acc[a][b][m][n] = (f32x4){0.f, 0.f, 0.f, 0.f};
        cur = nxt; cA = nA; cB = nB; ++ui;
        if constexpr (ALIGN_EPI) { if (wr == 1) PG8_BAR; }
    }
    PG8_WAIT_V(0);
    if constexpr (!ALIGN_EPI) { if (wr == 0) PG8_BAR; }
    PG8_BAR;
    if constexpr (Epi::AFTER_DRAIN) { E.fused(acc, cur, wr, wc, fr, fq, lds, wid, lane); S.done(cur); }
#undef PG8_SA
#undef PG8_SB
#undef PG8_STAGE
#undef PG8_LDA
#undef PG8_LDB
#undef PG8_MMA
#undef PG8_WAIT_V
#undef PG8_WAIT_L
#undef PG8_BAR
#undef PG8_SCHED
}
}

#define GAS __attribute__((address_space(1)))
#define LAS __attribute__((address_space(3)))
#define XB_TMO      128
#define XB_XCNT(j)  (256  + 64 * (j))
#define XB_XSUB(j)  (1280 + 64 * (j))
#define XB_XGEN(j)  (2304 + 64 * (j))
#define XB_TOP      3328
#define XB_TOPGEN   3392
#define XCD_BAR_WORDS 3456
#define XB_SPIN_CAP (1u << 18)

__device__ __forceinline__ unsigned xb_ld(unsigned* p)              { return __hip_atomic_load(p, __ATOMIC_RELAXED, __HIP_MEMORY_SCOPE_AGENT); }
__device__ __forceinline__ unsigned xb_add(unsigned* p, unsigned v) { return __hip_atomic_fetch_add(p, v, __ATOMIC_RELAXED, __HIP_MEMORY_SCOPE_AGENT); }
__device__ __forceinline__ unsigned xb_xcc_id() { return (unsigned)__builtin_amdgcn_s_getreg((3 << 11) | 20) & 0xFu; }
#define XB_SPIN(cond, bar) do { unsigned _sp = 0; while (cond) { __builtin_amdgcn_s_sleep(1); \
    if ((++_sp & 255u) == 0u) { if (xb_ld(&(bar)[XB_TMO])) break; if (_sp > XB_SPIN_CAP) { atomicAdd(&(bar)[XB_TMO], 1u); break; } } } } while (0)

struct XcdBarrier {
    unsigned* bar; unsigned x;
    volatile LAS unsigned* st;
};

__device__ __forceinline__ XcdBarrier xcd_barrier_post(unsigned* bar, volatile LAS unsigned* st) {
    XcdBarrier b; b.bar = bar; b.x = xb_xcc_id(); b.st = st;
    if (threadIdx.x == 0) (void)xb_add(&bar[XB_XCNT(b.x)], 1u);
    return b;
}
__device__ __forceinline__ void xcd_barrier_complete(unsigned* bar, unsigned x, unsigned& nloc, unsigned& nx) {
    const unsigned G = gridDim.x * gridDim.y * gridDim.z;
    unsigned sum, cnt, mine, sp = 0u;
    for (;;) {
        sum = 0u; cnt = 0u; mine = 0u;
#pragma unroll
        for (unsigned j = 0; j < 16; ++j) { const unsigned c = xb_ld(&bar[XB_XCNT(j)]); sum += c; cnt += (c > 0u) ? 1u : 0u; mine = (j == x) ? c : mine; }
        if (sum == G) break;
        __builtin_amdgcn_s_sleep(1);
        if ((++sp & 255u) == 0u) { if (xb_ld(&bar[XB_TMO])) break; if (sp > XB_SPIN_CAP) { atomicAdd(&bar[XB_TMO], 1u); break; } }
    }
    nloc = mine > 0u ? mine : 1u; nx = cnt > 0u ? cnt : 1u;
}

__device__ __forceinline__ void xcd_barrier(const XcdBarrier& b) {
    asm volatile("s_waitcnt vmcnt(0)" ::: "memory");
    __syncthreads();
    if (threadIdx.x == 0) {
        unsigned* bar = b.bar;
        __builtin_amdgcn_s_waitcnt(0);
        unsigned nloc = b.st[0], nx = b.st[1];
        if (nloc == 0u) { xcd_barrier_complete(bar, b.x, nloc, nx); b.st[0] = nloc; b.st[1] = nx; }
        const unsigned old = xb_add(&bar[XB_XSUB(b.x)], 1u);
        const unsigned gen = old / nloc;
        if (old + 1u == (gen + 1u) * nloc) {
            __builtin_amdgcn_fence(__ATOMIC_RELEASE, "agent");
            asm volatile("s_waitcnt vmcnt(0)" ::: "memory");
            const unsigned og = xb_add(&bar[XB_TOP], 1u);
            const unsigned tg = og / nx;
            if (og + 1u == (tg + 1u) * nx) xb_add(&bar[XB_TOPGEN], 1u);
            else XB_SPIN(xb_ld(&bar[XB_TOPGEN]) == tg, bar);
            __builtin_amdgcn_fence(__ATOMIC_ACQUIRE, "agent");
            xb_add(&bar[XB_XGEN(b.x)], 1u);
            asm volatile("s_waitcnt vmcnt(0)" ::: "memory");
        } else {
            XB_SPIN(xb_ld(&bar[XB_XGEN(b.x)]) == gen, bar);
            __builtin_amdgcn_fence(__ATOMIC_ACQUIRE, "agent");
            asm volatile("s_waitcnt vmcnt(0)" ::: "memory");
        }
    }
    __syncthreads();
}

constexpr int D = 1024, BATCH = 4, SEQ = 8192, NMETA = 16, LSEQ = SEQ + NMETA;
constexpr int T = BATCH * SEQ;
constexpr int NP = 2048, NQ = 2048, NEXP = 16384;
constexpr float EPS = 1e-6f;
constexpr int NWAVES = 8;

constexpr size_t MiB = 1u << 20;
constexpr size_t WS_CTL = 0, CTL_ZERO_BYTES = 1 * MiB;
constexpr int CW_BAR = 4096, CW_XS = 8192;
constexpr size_t WS_ROWSS = 512 * 1024;
constexpr size_t WS_WIN = 2 * MiB, WS_WOUT = 6 * MiB, WS_WQ = 8 * MiB, WS_KEYS = 12 * MiB, WS_RSTD1 = 13 * MiB;
constexpr size_t WS_UB = 16 * MiB  , WS_VB = 48 * MiB  , WS_XB = 80 * MiB  , WS_P = 144 * MiB  ;
constexpr size_t WS_H2B = 274 * MiB, WS_SELI = 338 * MiB, WS_SELG = 354 * MiB, WS_END = 370 * MiB;

constexpr int RING_BYTES = 131072, MISC_OFF = RING_BYTES + 320, LDS_BYTES = 147456;

typedef unsigned short bf16;
typedef unsigned v4u __attribute__((ext_vector_type(4)));
typedef unsigned v2u __attribute__((ext_vector_type(2)));
typedef float f32x4 __attribute__((ext_vector_type(4)));
typedef float f32x16 __attribute__((ext_vector_type(16)));
typedef short bf16x8 __attribute__((ext_vector_type(8)));
typedef __bf16 bf16x2_t __attribute__((ext_vector_type(2)));
#define LDS_WAIT() asm volatile("s_waitcnt lgkmcnt(0)" ::: "memory")

__device__ __forceinline__ unsigned f2bf(float f) { unsigned u = __builtin_bit_cast(unsigned, f); return (u + 0x7fffu + ((u >> 16) & 1u)) >> 16; }
__device__ __forceinline__ unsigned pk2(float lo, float hi) { return f2bf(lo) | (f2bf(hi) << 16); }
__device__ __forceinline__ float bflo(unsigned w) { return __builtin_bit_cast(float, w << 16); }
__device__ __forceinline__ float bfhi(unsigned w) { return __builtin_bit_cast(float, w & 0xffff0000u); }
__device__ __forceinline__ float wave_sum(float v) {
#pragma unroll
    for (int o = 1; o < 64; o <<= 1) v += __shfl_xor(v, o);
    return v;
}

struct EpiP {
    static constexpr bool PERM = true, AFTER_DRAIN = false;
    bf16* P; const float* rstd;
    __device__ __forceinline__ void operator()(const pg8::f32x4 (&acc)[2][2][4][2], const pg8::Unit& u, int wr, int wc, int fr, int fq) const {
        const int row0 = u.pm * 256 + wr * 64 + fr, col0 = u.pn * 256 + wc * 32 + 8 * fq;
#pragma unroll
        for (int ai = 0; ai < 2; ++ai)
#pragma unroll
            for (int m = 0; m < 4; ++m) {
                const int row = row0 + ai * 128 + m * 16; const float rs = rstd[row];
                bf16* rowp = P + ((size_t)(row >> 13) * LSEQ + NMETA + (row & 8191)) * NP + col0;
#pragma unroll
                for (int bj = 0; bj < 2; ++bj) { const pg8::f32x4 v0 = acc[ai][bj][m][0] * rs, v1 = acc[ai][bj][m][1] * rs;
                    v4u w; w.x = pg8::cvt_pk_bf16(v0[0], v0[1]); w.y = pg8::cvt_pk_bf16(v0[2], v0[3]); w.z = pg8::cvt_pk_bf16(v1[0], v1[1]); w.w = pg8::cvt_pk_bf16(v1[2], v1[3]);
                    *(v4u*)(rowp + bj * 128) = w; }
            }
    }
};
struct EpiH2 {
    static constexpr bool PERM = true, AFTER_DRAIN = false;
    const float* X; bf16* H2B; unsigned long long* rowss;
    __device__ __forceinline__ void operator()(const pg8::f32x4 (&acc)[2][2][4][2], const pg8::Unit& u, int wr, int wc, int fr, int fq) const {
        const int row0 = u.pm * 256 + wr * 64 + fr, col0 = u.pn * 256 + wc * 32 + 8 * fq;
#pragma unroll
        for (int ai = 0; ai < 2; ++ai)
#pragma unroll
            for (int m = 0; m < 4; ++m) {
                const int row = row0 + ai * 128 + m * 16; const size_t off = (size_t)row * D + col0; float ss = 0.f;
#pragma unroll
                for (int bj = 0; bj < 2; ++bj) {
                    const pg8::f32x4 x0 = *(const pg8::f32x4*)(X + off + bj * 128), x1 = *(const pg8::f32x4*)(X + off + bj * 128 + 4);
                    const pg8::f32x4 v0 = acc[ai][bj][m][0] + x0, v1 = acc[ai][bj][m][1] + x1;
                    v4u w; w.x = pg8::cvt_pk_bf16(v0[0], v0[1]); w.y = pg8::cvt_pk_bf16(v0[2], v0[3]); w.z = pg8::cvt_pk_bf16(v1[0], v1[1]); w.w = pg8::cvt_pk_bf16(v1[2], v1[3]);
                    *(v4u*)(H2B + off + bj * 128) = w;
                    ss += (v0[0] * v0[0] + v0[1] * v0[1]) + (v0[2] * v0[2] + v0[3] * v0[3]) + (v1[0] * v1[0] + v1[1] * v1[1]) + (v1[2] * v1[2] + v1[3] * v1[3]);
                }
                ss += __shfl_xor(ss, 16); ss += __shfl_xor(ss, 32);
                if (fq == 0) atomicAdd(rowss + row, (unsigned long long)(ss * 4294967296.0f));
            }
    }
};
struct EpiQ {
    static constexpr bool PERM = true, AFTER_DRAIN = false;
    bf16* Q; const unsigned long long* rowss;
    __device__ __forceinline__ void operator()(const pg8::f32x4 (&acc)[2][2][4][2], const pg8::Unit& u, int wr, int wc, int fr, int fq) const {
        const int row0 = u.pm * 256 + wr * 64 + fr, col0 = u.pn * 256 + wc * 32 + 8 * fq;
#pragma unroll
        for (int ai = 0; ai < 2; ++ai)
#pragma unroll
            for (int m = 0; m < 4; ++m) {
                const int row = row0 + ai * 128 + m * 16; const float rs = rsqrtf((float)rowss[row] * (1.0f / (4294967296.0f * D)) + EPS);
                bf16* rowp = Q + (size_t)row * NQ + col0;
#pragma unroll
                for (int bj = 0; bj < 2; ++bj) { const pg8::f32x4 v0 = acc[ai][bj][m][0] * rs, v1 = acc[ai][bj][m][1] * rs;
                    v4u w; w.x = pg8::cvt_pk_bf16(v0[0], v0[1]); w.y = pg8::cvt_pk_bf16(v0[2], v0[3]); w.z = pg8::cvt_pk_bf16(v1[0], v1[1]); w.w = pg8::cvt_pk_bf16(v1[2], v1[3]);
                    *(v4u*)(rowp + bj * 128) = w; }
            }
    }
};

__device__ __forceinline__ void row_to_bf16(const float* src, bf16* dst, const float* gain, float* rstd_out, int lane) {
    const f32x4* xr = (const f32x4*)src + lane;
    f32x4 v[4]; float s = 0.f;
#pragma unroll
    for (int j = 0; j < 4; ++j) { v[j] = xr[64 * j]; s += (v[j].x * v[j].x + v[j].y * v[j].y) + (v[j].z * v[j].z + v[j].w * v[j].w); }
    if (rstd_out) { s = wave_sum(s); if (lane == 0) *rstd_out = rsqrtf(s * (1.0f / D) + EPS); }
    if (gain) {
#pragma unroll
        for (int j = 0; j < 4; ++j) v[j] = v[j] * ((const f32x4*)gain)[lane + 64 * j];
    }
    unsigned long long* o8 = (unsigned long long*)dst + lane;
#pragma unroll
    for (int j = 0; j < 4; ++j) o8[64 * j] = (unsigned long long)pk2(v[j].x, v[j].y) | ((unsigned long long)pk2(v[j].z, v[j].w) << 32);
}
typedef float f32x2 __attribute__((ext_vector_type(2)));
constexpr float U8_SCALE = 64.0f, V8_SCALE = 8.0f;
__device__ __forceinline__ void row_to_fp8(const float* src, unsigned char* dst, const float* gain, float scale, int lane) {
    const f32x4* xr = (const f32x4*)src + lane;
    unsigned* o = (unsigned*)dst + lane;
#pragma unroll
    for (int j = 0; j < 4; ++j) { f32x4 v = xr[64 * j]; if (gain) v = v * ((const f32x4*)gain)[lane + 64 * j]; v = v * scale;
        int pk = 0; pk = __builtin_amdgcn_cvt_pk_fp8_f32(v.x, v.y, pk, false); pk = __builtin_amdgcn_cvt_pk_fp8_f32(v.z, v.w, pk, true);
        o[64 * j] = (unsigned)pk; }
}
__device__ __forceinline__ void row_load(const float* src, f32x4 (&v)[4], int lane) {
    const f32x4* xr = (const f32x4*)src + lane;
#pragma unroll
    for (int j = 0; j < 4; ++j) v[j] = __builtin_nontemporal_load(xr + 64 * j);
}
__device__ __forceinline__ void row_store_bf16(const f32x4 (&v)[4], bf16* dst, float* rstd_out, int lane) {
    float s = 0.f;
#pragma unroll
    for (int j = 0; j < 4; ++j) s += (v[j].x * v[j].x + v[j].y * v[j].y) + (v[j].z * v[j].z + v[j].w * v[j].w);
    if (rstd_out) { s = wave_sum(s); if (lane == 0) *rstd_out = rsqrtf(s * (1.0f / D) + EPS); }
    unsigned long long* o8 = (unsigned long long*)dst + lane;
#pragma unroll
    for (int j = 0; j < 4; ++j) o8[64 * j] = (unsigned long long)pk2(v[j].x, v[j].y) | ((unsigned long long)pk2(v[j].z, v[j].w) << 32);
}
__device__ __forceinline__ void row_store_fp8(const f32x4 (&v)[4], unsigned char* dst, const f32x4 (&gn)[4], float scale, int lane) {
    unsigned* o = (unsigned*)dst + lane;
#pragma unroll
    for (int j = 0; j < 4; ++j) { const f32x4 w = v[j] * gn[j] * scale;
        int pk = 0; pk = __builtin_amdgcn_cvt_pk_fp8_f32(w.x, w.y, pk, false); pk = __builtin_amdgcn_cvt_pk_fp8_f32(w.z, w.w, pk, true);
        o[64 * j] = (unsigned)pk; }
}
__device__ __forceinline__ void p0_transpose_item(const float* W, int K, int N, const float* gain, bf16* WT, LAS float* scr, int item, int lane) {
    const int nblk = N / 32, kb = item / nblk, nb = item % nblk, k0 = 64 * kb, n0 = 32 * nb;
    float tv_[32];
#pragma unroll
    for (int i = 0; i < 32; ++i) { const int kk = 2 * i + (lane >> 5); tv_[i] = W[(size_t)(k0 + kk) * N + n0 + (lane & 31)]; }
#pragma unroll
    for (int i = 0; i < 32; ++i) { const int kk = 2 * i + (lane >> 5); const float gk = gain ? gain[k0 + kk] : 1.0f; scr[kk * 33 + (lane & 31)] = tv_[i] * gk; }
    LDS_WAIT(); asm volatile("" ::: "memory");
    const int c = lane & 7;
#pragma unroll
    for (int j = 0; j < 4; ++j) { const int n = (lane >> 3) + 8 * j; const LAS float* s = scr + (8 * c) * 33 + n;
        v4u o; o.x = pk2(s[0 * 33], s[1 * 33]); o.y = pk2(s[2 * 33], s[3 * 33]); o.z = pk2(s[4 * 33], s[5 * 33]); o.w = pk2(s[6 * 33], s[7 * 33]);
        *(v4u*)(WT + (size_t)(n0 + n) * K + k0 + 8 * c) = o; }
    LDS_WAIT(); asm volatile("" ::: "memory");
}
__device__ __forceinline__ void p0_weff_item(const float* w_out, const float* pool_w, const float* pool_scale, bf16* WoutT, int item, int lane) {
    const int nb = item & 15, cg = (item >> 4) & 15, g = item >> 8;
    const int n = nb * 64 + lane;
    float acc[8];
#pragma unroll
    for (int i = 0; i < 8; ++i) acc[i] = 0.f;
    const float* wo = w_out + (size_t)(512 + g * 128) * D + n;
    const float* pw = pool_w + (size_t)(g * 128 + cg * 8) * 128;
    float pwr[8][2];
#pragma unroll
    for (int h = 0; h < 2; ++h) { const float psv = pool_scale[g * 128 + 64 * h + lane];
#pragma unroll
        for (int i = 0; i < 8; ++i) pwr[i][h] = pw[i * 128 + 64 * h + lane] * psv; }
#pragma unroll
    for (int h = 0; h < 2; ++h)
        for (int d0 = 0; d0 < 64; d0 += 32) { float wl_[32];
#pragma unroll
            for (int dd = 0; dd < 32; ++dd) wl_[dd] = wo[(size_t)(64 * h + d0 + dd) * D];
#pragma unroll
            for (int dd = 0; dd < 32; ++dd)
#pragma unroll
                for (int i = 0; i < 8; ++i) acc[i] += __builtin_bit_cast(float, __builtin_amdgcn_readlane(__builtin_bit_cast(int, pwr[i][h]), d0 + dd)) * wl_[dd]; }
    v4u o; o.x = pk2(acc[0], acc[1]); o.y = pk2(acc[2], acc[3]); o.z = pk2(acc[4], acc[5]); o.w = pk2(acc[6], acc[7]);
    *(v4u*)(WoutT + (size_t)n * D + 512 + g * 128 + cg * 8) = o;
}
__device__ __forceinline__ void p1_meta(const float* meta, const bf16* WinT, bf16* P, LAS unsigned char* lds, int blk, int tid) {
    LAS unsigned* mbw = (LAS unsigned*)lds;
    LAS float* rs = (LAS float*)(lds + 32768);
    const int wave = tid >> 6, lane = tid & 63;
    for (int i = tid; i < 16 * 512; i += 512) { const float lo = meta[2 * i], hi = meta[2 * i + 1]; mbw[i] = pk2(lo, hi); }
#pragma unroll
    for (int jj = 0; jj < 2; ++jj) { const int j = wave * 2 + jj; float s = 0.f;
        for (int k = lane; k < 1024; k += 64) { const float v = meta[j * 1024 + k]; s += v * v; }
        s = wave_sum(s); if (lane == 0) rs[j] = rsqrtf(s * (1.0f / D) + EPS); }
    __syncthreads();
    const int n = 8 * blk + wave;
    const v4u* wp = (const v4u*)(WinT + (size_t)n * D) + 2 * lane;
    const v4u wa = wp[0], wb = wp[1];
    const unsigned ww[8] = {wa.x, wa.y, wa.z, wa.w, wb.x, wb.y, wb.z, wb.w};
    float mine = 0.f;
#pragma unroll
    for (int j = 0; j < 16; ++j) {
        const v4u ma = *(const LAS v4u*)(lds + j * 2048 + lane * 32), mc = *(const LAS v4u*)(lds + j * 2048 + lane * 32 + 16);
        const unsigned mw[8] = {ma.x, ma.y, ma.z, ma.w, mc.x, mc.y, mc.z, mc.w};
        float d = 0.f;
#pragma unroll
        for (int q = 0; q < 8; ++q) d = __builtin_amdgcn_fdot2_f32_bf16(__builtin_bit_cast(bf16x2_t, ww[q]), __builtin_bit_cast(bf16x2_t, mw[q]), d, false);
        d = wave_sum(d);
        mine = (lane == j) ? d : mine;
    }
    if (lane < 16) { const bf16 o = (bf16)f2bf(mine * rs[lane]);
#pragma unroll
        for (int b = 0; b < BATCH; ++b) P[((size_t)b * LSEQ + lane) * NP + n] = o; }
    __syncthreads();
}

__device__ __forceinline__ void ld8(const bf16* p, float (&f)[8]) {
    const v4u w = *(const v4u*)p;
    f[0] = bflo(w.x); f[1] = bfhi(w.x); f[2] = bflo(w.y); f[3] = bfhi(w.y); f[4] = bflo(w.z); f[5] = bfhi(w.z); f[6] = bflo(w.w); f[7] = bfhi(w.w);
}
__device__ __forceinline__ void st8(bf16* p, const float (&f)[8]) {
    v4u o; o.x = pk2(f[0], f[1]); o.y = pk2(f[2], f[3]); o.z = pk2(f[4], f[5]); o.w = pk2(f[6], f[7]); *(v4u*)p = o;
}
__device__ __forceinline__ void p2_convpool(const bf16* __restrict__ P, const float* __restrict__ conv_w, const float* __restrict__ conv_b, bf16* __restrict__ Y, int blk, int tid) {
    const int cgp = tid & 127, run = tid >> 7;
    const int r_start = blk * 128 + run * 32;
    const int b = r_start >> 13, l0 = NMETA + (r_start & 8191);
    const bf16* Pb = P + (size_t)b * LSEQ * NP;
    if (cgp < 64) {
        const int c0 = cgp * 8;
        float w0[8], w1[8], w2[8], cb[8];
#pragma unroll
        for (int i = 0; i < 8; ++i) { w0[i] = conv_w[c0 + i]; w1[i] = conv_w[512 + c0 + i]; w2[i] = conv_w[1024 + c0 + i]; cb[i] = conv_b[c0 + i]; }
        float zp[8], zc[8], a[8], c[8];
        ld8(Pb + (size_t)(l0 - 1) * NP + c0, a); ld8(Pb + (size_t)(l0 - 1) * NP + 1024 + c0, c);
#pragma unroll
        for (int i = 0; i < 8; ++i) zp[i] = a[i] * c[i];
        ld8(Pb + (size_t)l0 * NP + c0, a); ld8(Pb + (size_t)l0 * NP + 1024 + c0, c);
#pragma unroll
        for (int i = 0; i < 8; ++i) zc[i] = a[i] * c[i];
        for (int t0 = 0; t0 < 32; t0 += 4) {
            v4u ra[4], rc[4], rb[4];
#pragma unroll
            for (int u = 0; u < 4; ++u) { const int l = l0 + t0 + u; const int ln = (l + 1 < LSEQ) ? l + 1 : l;
                ra[u] = *(const v4u*)(Pb + (size_t)ln * NP + c0); rc[u] = *(const v4u*)(Pb + (size_t)ln * NP + 1024 + c0); rb[u] = *(const v4u*)(Pb + (size_t)l * NP + 512 + c0); }
#pragma unroll
            for (int u = 0; u < 4; ++u) { const int l = l0 + t0 + u; const float vn = (l + 1 < LSEQ) ? 1.f : 0.f;
                const unsigned aw[4] = {ra[u].x, ra[u].y, ra[u].z, ra[u].w}, cw[4] = {rc[u].x, rc[u].y, rc[u].z, rc[u].w}, bw[4] = {rb[u].x, rb[u].y, rb[u].z, rb[u].w};
                float y[8];
#pragma unroll
                for (int i = 0; i < 4; ++i) {
                    const float zn0 = bflo(aw[i]) * bflo(cw[i]) * vn, zn1 = bfhi(aw[i]) * bfhi(cw[i]) * vn;
                    y[2 * i] = bflo(bw[i]) * (w0[2 * i] * zp[2 * i] + w1[2 * i] * zc[2 * i] + w2[2 * i] * zn0 + cb[2 * i]);
                    y[2 * i + 1] = bfhi(bw[i]) * (w0[2 * i + 1] * zp[2 * i + 1] + w1[2 * i + 1] * zc[2 * i + 1] + w2[2 * i + 1] * zn1 + cb[2 * i + 1]);
                    zp[2 * i] = zc[2 * i]; zc[2 * i] = zn0; zp[2 * i + 1] = zc[2 * i + 1]; zc[2 * i + 1] = zn1; }
                st8(Y + (size_t)(r_start + t0 + u) * D + c0, y); }
        }
    } else {
        const int c0 = (cgp - 64) * 8, g = c0 >> 7, hw = 1 << g;
        const bf16* Hb = Pb + 1536 + c0;
        float S[8], v[8];
#pragma unroll
        for (int i = 0; i < 8; ++i) S[i] = 0.f;
        { const int hi0 = (l0 + hw < LSEQ) ? l0 + hw : LSEQ;
          for (int j = l0 - hw; j < hi0; ++j) { ld8(Hb + (size_t)j * NP, v);
#pragma unroll
              for (int i = 0; i < 8; ++i) S[i] += v[i]; } }
        for (int t0 = 0; t0 < 32; t0 += 4) {
            v4u rc[4], rl[4], rh[4];
#pragma unroll
            for (int u = 0; u < 4; ++u) { const int l = l0 + t0 + u; const int lh = (l + hw < LSEQ) ? l + hw : l;
                rc[u] = *(const v4u*)(Hb + (size_t)l * NP); rl[u] = *(const v4u*)(Hb + (size_t)(l - hw) * NP); rh[u] = *(const v4u*)(Hb + (size_t)lh * NP); }
#pragma unroll
            for (int u = 0; u < 4; ++u) { const int l = l0 + t0 + u; const int hi = (l + hw < LSEQ) ? l + hw : LSEQ; const float inv = 1.0f / (float)(hi - (l - hw)); const float vh = (l + hw < LSEQ) ? 1.f : 0.f;
                const unsigned cw[4] = {rc[u].x, rc[u].y, rc[u].z, rc[u].w}, lw[4] = {rl[u].x, rl[u].y, rl[u].z, rl[u].w}, hwd[4] = {rh[u].x, rh[u].y, rh[u].z, rh[u].w};
                float m[8];
#pragma unroll
                for (int i = 0; i < 4; ++i) {
                    m[2 * i] = S[2 * i] * inv - bflo(cw[i]); m[2 * i + 1] = S[2 * i + 1] * inv - bfhi(cw[i]);
                    S[2 * i] += bflo(hwd[i]) * vh - bflo(lw[i]); S[2 * i + 1] += bfhi(hwd[i]) * vh - bfhi(lw[i]); }
                st8(Y + (size_t)(r_start + t0 + u) * D + 512 + c0, m); }
        }
    }
}

#define MFMA32(a, b, c) __builtin_amdgcn_mfma_f32_32x32x16_bf16((a), (b), (c), 0, 0, 0)
__device__ __forceinline__ float mkcand(float a, float b, unsigned tag) { return __builtin_bit_cast(float, (__builtin_bit_cast(unsigned, a + b) & ~0xFFu) | tag); }
__device__ __forceinline__ unsigned keylook(unsigned long long lo, unsigned long long hi, unsigned i) {
    const unsigned long long w = (i < 8u) ? lo : hi;
    return (unsigned)(w >> (8u * (i & 7u))) & 127u;
}
#define CE_DESC(a, b) do { const float hi_ = fmaxf((a), (b)), lo_ = fminf((a), (b)); (a) = hi_; (b) = lo_; } while (0)
__device__ __forceinline__ void sort16_desc(float (&v)[16]) {
    CE_DESC(v[0], v[13]); CE_DESC(v[1], v[12]); CE_DESC(v[2], v[15]); CE_DESC(v[3], v[14]); CE_DESC(v[4], v[8]); CE_DESC(v[5], v[6]); CE_DESC(v[7], v[11]); CE_DESC(v[9], v[10]);
    CE_DESC(v[0], v[5]); CE_DESC(v[1], v[7]); CE_DESC(v[2], v[9]); CE_DESC(v[3], v[4]); CE_DESC(v[6], v[13]); CE_DESC(v[8], v[14]); CE_DESC(v[10], v[15]); CE_DESC(v[11], v[12]);
    CE_DESC(v[0], v[1]); CE_DESC(v[2], v[3]); CE_DESC(v[4], v[5]); CE_DESC(v[6], v[8]); CE_DESC(v[7], v[9]); CE_DESC(v[10], v[11]); CE_DESC(v[12], v[13]); CE_DESC(v[14], v[15]);
    CE_DESC(v[0], v[2]); CE_DESC(v[1], v[3]); CE_DESC(v[4], v[10]); CE_DESC(v[5], v[11]); CE_DESC(v[6], v[7]); CE_DESC(v[8], v[9]); CE_DESC(v[12], v[14]); CE_DESC(v[13], v[15]);
    CE_DESC(v[1], v[2]); CE_DESC(v[3], v[12]); CE_DESC(v[4], v[6]); CE_DESC(v[5], v[7]); CE_DESC(v[8], v[10]); CE_DESC(v[9], v[11]); CE_DESC(v[13], v[14]);
    CE_DESC(v[1], v[4]); CE_DESC(v[2], v[6]); CE_DESC(v[5], v[8]); CE_DESC(v[7], v[10]); CE_DESC(v[9], v[13]); CE_DESC(v[11], v[14]);
    CE_DESC(v[2], v[4]); CE_DESC(v[3], v[6]); CE_DESC(v[9], v[12]); CE_DESC(v[11], v[13]);
    CE_DESC(v[3], v[5]); CE_DESC(v[6], v[8]); CE_DESC(v[7], v[9]); CE_DESC(v[10], v[12]);
    CE_DESC(v[3], v[4]); CE_DESC(v[5], v[6]); CE_DESC(v[7], v[8]); CE_DESC(v[9], v[10]); CE_DESC(v[11], v[12]);
    CE_DESC(v[6], v[7]); CE_DESC(v[8], v[9]);
}
__device__ __forceinline__ void merge16_desc(float (&t)[16], const float (&o)[16]) {
#pragma unroll
    for (int i = 0; i < 16; ++i) t[i] = fmaxf(t[i], o[15 - i]);
#pragma unroll
    for (int j = 8; j > 0; j >>= 1)
#pragma unroll
        for (int i = 0; i < 16; ++i) { const int l = i ^ j; if (l > i) CE_DESC(t[i], t[l]); }
}
__device__ __forceinline__ void p5_item(const bf16* Q, const LAS unsigned char* kl, LAS unsigned char* ql, int* SI, float* SG, int tg, int head, int lane) {
    const int r = lane & 31, h = lane >> 5;
    const int tok = tg * 32 + r;
    const float NEG = -__builtin_inff();
    float sv[2][16];
#pragma unroll
    for (int p = 0; p < 2; ++p) {
        const int hp = head * 2 + p;
        f32x16 acc[4];
#pragma unroll
        for (int kt = 0; kt < 4; ++kt)
#pragma unroll
            for (int i = 0; i < 16; ++i) acc[kt][i] = 0.f;
        {
            v4u qv[8];
#pragma unroll
            for (int i = 0; i < 8; ++i) { const int ch = i * 64 + lane, row = ch >> 4, c = ch & 15;
                qv[i] = *(const v4u*)(Q + (size_t)(tg * 32 + row) * NQ + hp * 128 + c * 8); }
#pragma unroll
            for (int i = 0; i < 8; ++i) { const int ch = i * 64 + lane, row = ch >> 4, c = ch & 15;
                *(LAS v4u*)(ql + row * 256 + ((c ^ (row & 15)) << 4)) = qv[i]; }
        }
        const LAS unsigned char* kp = kl + p * 32768 + r * 256;
        const LAS unsigned char* qp = ql + r * 256;
#pragma unroll
        for (int s = 0; s < 8; ++s) {
            const int co = ((2 * s + h) ^ (r & 15)) << 4;
            const bf16x8 bq = *(const LAS bf16x8*)(qp + co);
#pragma unroll
            for (int kt = 0; kt < 4; ++kt) { const bf16x8 ak = *(const LAS bf16x8*)(kp + kt * 8192 + co); acc[kt] = MFMA32(ak, bq, acc[kt]); }
        }
        __builtin_amdgcn_sched_barrier(0);
        float t[16];
#pragma unroll
        for (int kt = 0; kt < 4; ++kt) {
            float g[16];
#pragma unroll
            for (int i = 0; i < 16; ++i) { const unsigned key = 32u * kt + (i & 3) + 8u * (i >> 2) + 4u * h;
                const float av = acc[kt][i];
                g[i] = __builtin_bit_cast(float, (__builtin_bit_cast(unsigned, av) & ~127u) | key); }
            sort16_desc(g);
            if (kt == 0) {
#pragma unroll
                for (int i = 0; i < 16; ++i) t[i] = g[i];
            } else merge16_desc(t, g);
        }
        float o[16];
#pragma unroll
        for (int i = 0; i < 16; ++i) o[i] = __shfl_xor(t[i], 32);
        merge16_desc(t, o);
#pragma unroll
        for (int i = 0; i < 16; ++i) sv[p][i] = t[i];
        __builtin_amdgcn_sched_barrier(0);
    }
    unsigned long long K0lo = 0ull, K0hi = 0ull, K1lo = 0ull, K1hi = 0ull;
#pragma unroll
    for (int i = 0; i < 8; ++i) {
        K0lo |= (unsigned long long)(__builtin_bit_cast(unsigned, sv[0][i]) & 127u) << (8 * i); K0hi |= (unsigned long long)(__builtin_bit_cast(unsigned, sv[0][8 + i]) & 127u) << (8 * i);
        K1lo |= (unsigned long long)(__builtin_bit_cast(unsigned, sv[1][i]) & 127u) << (8 * i); K1hi |= (unsigned long long)(__builtin_bit_cast(unsigned, sv[1][8 + i]) & 127u) << (8 * i); }
    float sel[16];
    {
        float ca[16], cb[16];
        ca[0] = h ? mkcand(sv[0][1], sv[1][0], 16u) : mkcand(sv[0][0], sv[1][0], 0u);
        ca[1] = h ? mkcand(sv[0][2], sv[1][0], 32u) : mkcand(sv[0][0], sv[1][1], 1u);
        ca[2] = h ? mkcand(sv[0][3], sv[1][0], 48u) : mkcand(sv[0][0], sv[1][2], 2u);
        ca[3] = h ? mkcand(sv[0][4], sv[1][0], 64u) : mkcand(sv[0][0], sv[1][3], 3u);
        ca[4] = h ? mkcand(sv[0][5], sv[1][0], 80u) : mkcand(sv[0][0], sv[1][4], 4u);
        ca[5] = h ? mkcand(sv[0][6], sv[1][0], 96u) : mkcand(sv[0][0], sv[1][5], 5u);
        ca[6] = h ? mkcand(sv[0][7], sv[1][0], 112u) : mkcand(sv[0][0], sv[1][6], 6u);
        ca[7] = h ? mkcand(sv[0][8], sv[1][0], 128u) : mkcand(sv[0][0], sv[1][7], 7u);
        ca[8] = h ? mkcand(sv[0][9], sv[1][0], 144u) : mkcand(sv[0][0], sv[1][8], 8u);
        ca[9] = h ? mkcand(sv[0][10], sv[1][0], 160u) : mkcand(sv[0][0], sv[1][9], 9u);
        ca[10] = h ? mkcand(sv[0][11], sv[1][0], 176u) : mkcand(sv[0][0], sv[1][10], 10u);
        ca[11] = h ? mkcand(sv[0][12], sv[1][0], 192u) : mkcand(sv[0][0], sv[1][11], 11u);
        ca[12] = h ? mkcand(sv[0][13], sv[1][0], 208u) : mkcand(sv[0][0], sv[1][12], 12u);
        ca[13] = h ? mkcand(sv[0][14], sv[1][0], 224u) : mkcand(sv[0][0], sv[1][13], 13u);
        ca[14] = h ? mkcand(sv[0][15], sv[1][0], 240u) : mkcand(sv[0][0], sv[1][14], 14u);
        ca[15] = h ? NEG : mkcand(sv[0][0], sv[1][15], 15u);
        cb[0] = h ? mkcand(sv[0][1], sv[1][2], 18u) : mkcand(sv[0][1], sv[1][1], 17u);
        cb[1] = h ? mkcand(sv[0][1], sv[1][4], 20u) : mkcand(sv[0][1], sv[1][3], 19u);
        cb[2] = h ? mkcand(sv[0][1], sv[1][6], 22u) : mkcand(sv[0][1], sv[1][5], 21u);
        cb[3] = h ? mkcand(sv[0][2], sv[1][1], 33u) : mkcand(sv[0][1], sv[1][7], 23u);
        cb[4] = h ? mkcand(sv[0][2], sv[1][3], 35u) : mkcand(sv[0][2], sv[1][2], 34u);
        cb[5] = h ? mkcand(sv[0][3], sv[1][1], 49u) : mkcand(sv[0][2], sv[1][4], 36u);
        cb[6] = h ? mkcand(sv[0][3], sv[1][3], 51u) : mkcand(sv[0][3], sv[1][2], 50u);
        cb[7] = h ? mkcand(sv[0][4], sv[1][2], 66u) : mkcand(sv[0][4], sv[1][1], 65u);
        cb[8] = h ? mkcand(sv[0][6], sv[1][1], 97u) : mkcand(sv[0][5], sv[1][1], 81u);
        cb[9] = h ? NEG : mkcand(sv[0][7], sv[1][1], 113u);
        cb[10] = NEG;
        cb[11] = NEG;
        cb[12] = NEG;
        cb[13] = NEG;
        cb[14] = NEG;
        cb[15] = NEG;
        sort16_desc(cb); merge16_desc(ca, cb);
        float co[16];
#pragma unroll
        for (int i = 0; i < 16; ++i) co[i] = __shfl_xor(ca[i], 32);
        merge16_desc(ca, co);
#pragma unroll
        for (int i = 0; i < 16; ++i) sel[i] = ca[i];
    }
    float e[16], esum = 0.f; int eidx[16];
#pragma unroll
    for (int t = 0; t < 16; ++t) { e[t] = __expf(sel[t] - sel[0]); esum += e[t];
        const unsigned tag = __builtin_bit_cast(unsigned, sel[t]) & 0xFFu;
        eidx[t] = (int)(keylook(K0lo, K0hi, tag >> 4) * 128u + keylook(K1lo, K1hi, tag & 15u)); }
    const float inv = 1.0f / esum;
    if (h == 0) { int* o = SI + (size_t)tok * 128 + head * 16;
#pragma unroll
        for (int t = 0; t < 16; t += 4) *(int4*)(o + t) = make_int4(eidx[t], eidx[t + 1], eidx[t + 2], eidx[t + 3]); }
    else { float* o = SG + (size_t)tok * 128 + head * 16;
#pragma unroll
        for (int t = 0; t < 16; t += 4) *(f32x4*)(o + t) = (f32x4){e[t] * inv, e[t + 1] * inv, e[t + 2] * inv, e[t + 3] * inv}; }
}

__device__ __forceinline__ void p5_block(const bf16* Q, const bf16* KB, int* SI, float* SG, LAS unsigned char* lds, int vb, int tid, const float* pu, const float* pv, const float* g2, unsigned char* U8, unsigned char* V8, int G) {
    const int head = vb & 7, wave = tid >> 6, lane = tid & 63;
    __syncthreads();
#pragma unroll
    for (int i = 0; i < 8; ++i) { const int cid = tid + 512 * i, hpl = cid >> 11, row = (cid >> 4) & 127, c = cid & 15;
        const v4u val = *(const v4u*)(KB + ((size_t)(head * 2 + hpl) * 128 + row) * 128 + c * 8);
        *(LAS v4u*)(lds + hpl * 32768 + row * 256 + ((c ^ (row & 15)) << 4)) = val; }
    __syncthreads();
    LAS unsigned char* ql = lds + 65536 + wave * 8192;
    const int NGW = 256 * NWAVES, gwv = vb * NWAVES + wave;
    for (int n = 0; n < 4; ++n) {
        { const int m = gwv + 2 * n * NGW;
          p5_item(Q, lds, ql, SI, SG, (vb >> 3) + 32 * (wave + 8 * n), head, lane);
          __builtin_amdgcn_sched_barrier(0);
          f32x4 va[4], vb_[4], vc[4], vd[4];
          row_load(pu + (size_t)m * D, va, lane); row_load(pu + (size_t)(m + NGW) * D, vb_, lane); row_load(pv + (size_t)m * D, vc, lane); row_load(pv + (size_t)(m + NGW) * D, vd, lane);
          { f32x4 gv_[4];
#pragma unroll
            for (int j = 0; j < 4; ++j) gv_[j] = ((const f32x4*)g2)[lane + 64 * j];
            row_store_fp8(va, U8 + (size_t)m * D, gv_, U8_SCALE, lane); row_store_fp8(vb_, U8 + (size_t)(m + NGW) * D, gv_, U8_SCALE, lane);
#pragma unroll
            for (int j = 0; j < 4; ++j) gv_[j] = (f32x4){1.f, 1.f, 1.f, 1.f};
            row_store_fp8(vc, V8 + (size_t)m * D, gv_, V8_SCALE, lane); row_store_fp8(vd, V8 + (size_t)(m + NGW) * D, gv_, V8_SCALE, lane); }
          __builtin_amdgcn_sched_barrier(0); }
    }
}

__device__ __forceinline__ f32x2 cvt8(unsigned w, bool hi) { return hi ? __builtin_amdgcn_cvt_pk_f32_fp8((int)w, true) : __builtin_amdgcn_cvt_pk_f32_fp8((int)w, false); }
#ifndef RED_SWAP
#define RED_SWAP 1
#define RED_DPP 1
#endif
typedef unsigned u32x2 __attribute__((ext_vector_type(2)));
typedef _Float16 h16x2 __attribute__((ext_vector_type(2)));
__device__ __forceinline__ float gelu_erf(float v) {
    const float av = __builtin_fabsf(v), t = __builtin_amdgcn_rcpf(av * 0.2316418882f + 1.0f);
    float q = t * 0.5307027145f + (-0.7265760135f); q = q * t + 0.7107068705f; q = q * t + (-0.142248368f); q = q * t + 0.127414796f; q = q * t;
    const float e = __builtin_amdgcn_exp2f((v * v) * (-0.72134752044f));
    const float m = v * (q * e);
    return v < 0.f ? m : v - m;
}
#define DPP_ADD(v, ctrl) ((v) + __builtin_bit_cast(float, __builtin_amdgcn_mov_dpp(__builtin_bit_cast(int, (v)), (ctrl), 0xF, 0xF, true)))
__device__ __forceinline__ float swap32_add(float a, float b) { const u32x2 r = __builtin_amdgcn_permlane32_swap(__builtin_bit_cast(unsigned, a), __builtin_bit_cast(unsigned, b), false, false);
    const unsigned r0 = r[0], r1 = r[1]; return __builtin_bit_cast(float, r0) + __builtin_bit_cast(float, r1); }
__device__ __forceinline__ float swap16_add(float a, float b) { const u32x2 r = __builtin_amdgcn_permlane16_swap(__builtin_bit_cast(unsigned, a), __builtin_bit_cast(unsigned, b), false, false);
    const unsigned r0 = r[0], r1 = r[1]; return __builtin_bit_cast(float, r0) + __builtin_bit_cast(float, r1); }
__device__ __forceinline__ void sort128(unsigned& k0, unsigned& k1, int lane) {
#pragma unroll
    for (int k = 1; k <= 7; ++k)
#pragma unroll
        for (int j = k - 1; j >= 0; --j) {
            if (j == 6) { const unsigned lo = k0 < k1 ? k0 : k1, hi = k0 < k1 ? k1 : k0; k0 = lo; k1 = hi; }
            else {
                const unsigned o0 = (unsigned)__shfl_xor((int)k0, 1 << j), o1 = (unsigned)__shfl_xor((int)k1, 1 << j);
                const bool lower = ((lane >> j) & 1) == 0;
                const bool up0 = (k == 7) ? true : ((k == 6) ? true : (((lane >> k) & 1) == 0));
                const bool up1 = (k == 7) ? true : ((k == 6) ? false : (((lane >> k) & 1) == 0));
                const unsigned mn0 = k0 < o0 ? k0 : o0, mx0 = k0 < o0 ? o0 : k0, mn1 = k1 < o1 ? k1 : o1, mx1 = k1 < o1 ? o1 : k1;
                k0 = (lower == up0) ? mn0 : mx0; k1 = (lower == up1) ? mn1 : mx1;
            }
        }
}
__device__ __forceinline__ void xcd_align(unsigned* cnt, unsigned nloc, unsigned& epoch) {
    __syncthreads();
    ++epoch;
    if (threadIdx.x == 0) {
        __hip_atomic_fetch_add(cnt, 1u, __ATOMIC_RELAXED, __HIP_MEMORY_SCOPE_AGENT);
        const unsigned target = nloc * epoch; unsigned sp = 0;
        while (__hip_atomic_load(cnt, __ATOMIC_RELAXED, __HIP_MEMORY_SCOPE_AGENT) < target && ++sp < (1u << 14)) __builtin_amdgcn_s_sleep(2);
    }
    __syncthreads();
}
constexpr int P6K = 4;
#define P6_ROWLOAD(TAB, J, B) do { _Pragma("unroll") for (int k = 0; k < 4; ++k) { const int e_ = 4 * (B) + k; \
        const int idx_ = __builtin_amdgcn_readlane(((B) < 16) ? idx0[J] : idx1[J], e_ & 63); \
        rows[J][k] = ((const v4u*)((TAB) + (size_t)idx_ * D))[lane]; } } while (0)
__device__ __forceinline__ void p6_round(const bf16* H2B, const unsigned long long* rowss, const int* SI, const float* SG, const unsigned char* U8, const unsigned char* V8, const float* gf, float* OUT,
                                         int tok0, int lane, LAS unsigned char* stg, int& pend_tok0, unsigned* xcnt, unsigned nloc, unsigned& epoch, unsigned long long (&pt)[6]) {
#ifdef PROBE_SEL
    unsigned long long t_a = __builtin_amdgcn_s_memrealtime(), t_b;
#define PT(i) do { t_b = __builtin_amdgcn_s_memrealtime(); pt[i] += t_b - t_a; t_a = t_b; } while (0)
#else
#define PT(i) do {} while (0)
#endif
    h16x2 xh[P6K][8]; int idx0[P6K], idx1[P6K]; float gs0[P6K], gs1[P6K], asc[P6K];
#pragma unroll
    for (int j = 0; j < P6K; ++j) { const int tok = tok0 + j;
        const v4u* hb = (const v4u*)(H2B + (size_t)tok * D) + 2 * lane;
        const v4u xa = hb[0], xb = hb[1];
        { const unsigned xw_[8] = {xa.x, xa.y, xa.z, xa.w, xb.x, xb.y, xb.z, xb.w};
#pragma unroll
          for (int q = 0; q < 8; ++q) xh[j][q] = (h16x2){(_Float16)bflo(xw_[q]), (_Float16)bfhi(xw_[q])}; }
        unsigned k0 = ((unsigned)SI[(size_t)tok * 128 + lane] << 7) | (unsigned)lane, k1 = ((unsigned)SI[(size_t)tok * 128 + 64 + lane] << 7) | (unsigned)(64 + lane);
        sort128(k0, k1, lane);
        idx0[j] = (int)(k0 >> 7); idx1[j] = (int)(k1 >> 7);
        gs0[j] = SG[(size_t)tok * 128 + (k0 & 127u)]; gs1[j] = SG[(size_t)tok * 128 + (k1 & 127u)];
        asc[j] = rsqrtf((float)rowss[tok] * (1.0f / (4294967296.0f * D)) + EPS) * (1.0f / U8_SCALE); }
    const int rw = lane >> 4;
#ifdef OLD_REDUCE
    const int kl = ((lane >> 5) & 1) + 2 * ((lane >> 4) & 1);
#else
    const int kl = ((rw & 1) << 1) | (rw >> 1);
#endif
    const int kl_unused_ = 0; (void)kl_unused_;
#ifdef OLD_REDUCE
    const int lh = 32 * (lane & 1) + 16 * ((lane >> 1) & 1);
#else
    const int lh = 16 * ((((lane & 3) & 1) << 1) | ((lane & 3) >> 1));
#endif
    float w0[P6K], w1[P6K];
#pragma unroll
    for (int j = 0; j < P6K; ++j) { w0[j] = 0.f; w1[j] = 0.f; }
    v4u rows[P6K][4];
    PT(0);
    if (epoch == 0u) xcd_align(xcnt, nloc, epoch); else __builtin_amdgcn_s_barrier();
    PT(1);
#pragma unroll
    for (int j = 0; j < P6K; ++j) P6_ROWLOAD(U8, j, 0);
    for (int b = 0; b < 32; ++b) {
        if ((b & 7) == 0) __builtin_amdgcn_s_barrier();
        if (pend_tok0 >= 0) {
            const v2u d_ = *(const LAS v2u*)(stg + b * 512 + lane * 8);
            *(v2u*)((char*)OUT + (size_t)pend_tok0 * (D * 4) + b * 512 + lane * 8) = d_; }
#pragma unroll
        for (int j = 0; j < P6K; ++j) {
            float d_[4];
#pragma unroll
            for (int k = 0; k < 4; ++k) { float a_ = 0.f; const unsigned uw_[4] = {rows[j][k].x, rows[j][k].y, rows[j][k].z, rows[j][k].w};
#pragma unroll
                for (int q = 0; q < 4; ++q) { a_ = __builtin_amdgcn_fdot2(__builtin_amdgcn_cvt_scalef32_pk_f16_fp8(uw_[q], 1.0f, false), xh[j][2 * q], a_, false);
                                              a_ = __builtin_amdgcn_fdot2(__builtin_amdgcn_cvt_scalef32_pk_f16_fp8(uw_[q], 1.0f, true), xh[j][2 * q + 1], a_, false); }
                d_[k] = a_; }
            if (b + 1 < 32) P6_ROWLOAD(U8, j, b + 1);
            float s_;
#if RED_SWAP == 1
            s_ = swap16_add(swap32_add(d_[0], d_[1]), swap32_add(d_[2], d_[3]));
#elif RED_SWAP == 2
            { const bool h4 = (lane & 16) != 0; const float r0_ = swap32_add(d_[0], d_[1]), r1_ = swap32_add(d_[2], d_[3]);
              const float a_ = h4 ? r1_ : r0_, b_ = h4 ? r0_ : r1_; s_ = a_ + __shfl_xor(b_, 16); }
#else
            { const bool h5 = (lane & 32) != 0, h4 = (lane & 16) != 0; float r_[2];
              for (int i = 0; i < 2; ++i) { const float a_ = h5 ? d_[2 * i + 1] : d_[2 * i], b_ = h5 ? d_[2 * i] : d_[2 * i + 1]; r_[i] = a_ + __shfl_xor(b_, 32); }
              { const float a_ = h4 ? r_[1] : r_[0], b_ = h4 ? r_[0] : r_[1]; s_ = a_ + __shfl_xor(b_, 16); } }
#endif
#if RED_DPP
            s_ = DPP_ADD(s_, 0x128); s_ = DPP_ADD(s_, 0x124); s_ = DPP_ADD(s_, 0x4E); s_ = DPP_ADD(s_, 0xB1);
#else
            s_ += __shfl_xor(s_, 8); s_ += __shfl_xor(s_, 4); s_ += __shfl_xor(s_, 2); s_ += __shfl_xor(s_, 1);
#endif
            const float wp_ = __shfl(s_, lh);
            const bool mine = (lane >> 2) == (b & 15);
            w0[j] = (mine && b < 16) ? wp_ : w0[j]; w1[j] = (mine && b >= 16) ? wp_ : w1[j];
        }
    }
#pragma unroll
    for (int j = 0; j < P6K; ++j) { w0[j] = gs0[j] * gelu_erf(w0[j] * asc[j]) * (1.0f / V8_SCALE); w1[j] = gs1[j] * gelu_erf(w1[j] * asc[j]) * (1.0f / V8_SCALE); }
    PT(2);
#ifdef ALIGN_V
    xcd_align(xcnt, nloc, epoch);
#else
    __builtin_amdgcn_s_barrier();
#endif
    PT(3);
    f32x2 o2[P6K][8];
#pragma unroll
    for (int j = 0; j < P6K; ++j) {
#pragma unroll
        for (int q = 0; q < 8; ++q) o2[j][q] = (f32x2){0.f, 0.f};
        P6_ROWLOAD(V8, j, 0); }
    for (int b = 0; b < 32; ++b) {
        if ((b & 7) == 0) __builtin_amdgcn_s_barrier();
#pragma unroll
        for (int j = 0; j < P6K; ++j) {
#pragma unroll
            for (int k = 0; k < 4; ++k) { const float w_ = __builtin_bit_cast(float, __builtin_amdgcn_readlane(__builtin_bit_cast(int, (b < 16) ? w0[j] : w1[j]), (4 * b + k) & 63));
                const unsigned vw_[4] = {rows[j][k].x, rows[j][k].y, rows[j][k].z, rows[j][k].w};
#pragma unroll
                for (int q = 0; q < 4; ++q) { o2[j][2 * q] = cvt8(vw_[q], false) * w_ + o2[j][2 * q]; o2[j][2 * q + 1] = cvt8(vw_[q], true) * w_ + o2[j][2 * q + 1]; } }
            if (b + 1 < 32) P6_ROWLOAD(V8, j, b + 1);
        }
    }
    PT(4);
    const f32x4* gp = (const f32x4*)gf + 4 * lane;
#pragma unroll
    for (int j = 0; j < P6K; ++j) {
        f32x4* op = (f32x4*)(OUT + (size_t)(tok0 + j) * D) + 4 * lane;
        const v4u* hb = (const v4u*)(H2B + (size_t)(tok0 + j) * D) + 2 * lane;
        const v4u ha = hb[0], hc = hb[1];
        const unsigned hw[8] = {ha.x, ha.y, ha.z, ha.w, hc.x, hc.y, hc.z, hc.w};
        f32x4 y[4]; float ss = 0.f;
#pragma unroll
        for (int q = 0; q < 4; ++q) { y[q] = (f32x4){bflo(hw[2 * q]) + o2[j][2 * q].x, bfhi(hw[2 * q]) + o2[j][2 * q].y, bflo(hw[2 * q + 1]) + o2[j][2 * q + 1].x, bfhi(hw[2 * q + 1]) + o2[j][2 * q + 1].y};
            ss += (y[q].x * y[q].x + y[q].y * y[q].y) + (y[q].z * y[q].z + y[q].w * y[q].w); }
        ss = wave_sum(ss);
        const float rs = rsqrtf(ss * (1.0f / D) + EPS);
#pragma unroll
        for (int q = 0; q < 4; ++q) *(LAS f32x4*)(stg + j * 4096 + lane * 64 + q * 16) = y[q] * rs * gp[q];
        (void)op;
    }
    pend_tok0 = tok0;
    PT(5);
}

struct Args { const float* in[15]; float* out; unsigned char* ws; int ph_lo, ph_hi; };
constexpr int NPHASE = 7;
#ifndef MK_N_LAUNCHES
#define MK_N_LAUNCHES 1
#endif

__global__ void __launch_bounds__(NWAVES * 64, 2) fwd_kernel(Args args) {
    extern __shared__ __attribute__((aligned(16))) unsigned char lds_raw[];
    LAS unsigned char* lds = (LAS unsigned char*)lds_raw;
    volatile LAS unsigned* MISC = (volatile LAS unsigned*)(lds + MISC_OFF);
    const int tid = threadIdx.x, lane = tid & 63, wave = __builtin_amdgcn_readfirstlane(tid >> 6);
    const int G = gridDim.x, blk = blockIdx.x;
    unsigned char* ws = args.ws;
    const float* x = args.in[0]; const float* meta = args.in[1]; const float* g1 = args.in[2]; const float* w_in = args.in[3];
    const float* conv_w = args.in[4]; const float* conv_b = args.in[5]; const float* pool_w = args.in[6]; const float* pool_scale = args.in[7];
    const float* w_out = args.in[8]; const float* g2 = args.in[9]; const float* w_q = args.in[10]; const float* keys = args.in[11];
    const float* pu = args.in[12]; const float* pv = args.in[13]; const float* gf = args.in[14];
    bf16* WinT = (bf16*)(ws + WS_WIN); bf16* WoutT = (bf16*)(ws + WS_WOUT); bf16* WqT = (bf16*)(ws + WS_WQ); bf16* KB = (bf16*)(ws + WS_KEYS);
    float* rstd1 = (float*)(ws + WS_RSTD1); unsigned long long* rowss = (unsigned long long*)(ws + WS_ROWSS);
    unsigned char* U8 = ws + WS_UB; unsigned char* V8 = ws + WS_VB; bf16* XB = (bf16*)(ws + WS_XB); bf16* YP = (bf16*)(ws + WS_XB);
    bf16* P = (bf16*)(ws + WS_P); bf16* Qb = (bf16*)(ws + WS_P); bf16* H2B = (bf16*)(ws + WS_H2B);
    int* SI = (int*)(ws + WS_SELI); float* SG = (float*)(ws + WS_SELG);

    for (int u = tid; u < (LDS_BYTES - RING_BYTES) / 4; u += NWAVES * 64) ((LAS unsigned*)(lds + RING_BYTES))[u] = 0u;
    __syncthreads();
    const int lo = args.ph_lo, hi = args.ph_hi;
#if defined(PROBE_SEL) && PROBE_SEL == 9
    if (tid == 0) atomicMax((unsigned long long*)(ws + WS_CTL + 64), ~(unsigned long long)__builtin_amdgcn_s_memrealtime());
#endif
#ifdef PROBE_SEL
    const unsigned long long t_kstart = __builtin_amdgcn_s_memrealtime(); unsigned long long t_p6start = 0ull; unsigned long long tsp[8]; tsp[0] = t_kstart;
#define TSP(i) tsp[i] = __builtin_amdgcn_s_memrealtime()
#else
#define TSP(i) do {} while (0)
#endif
    XcdBarrier bar; bar.bar = (unsigned*)(ws + WS_CTL) + CW_BAR; bar.x = 0; bar.st = nullptr;
    if (hi - lo > 1) bar = xcd_barrier_post((unsigned*)(ws + WS_CTL) + CW_BAR, MISC + 8);
#define IN(k) (lo <= (k) && (k) < hi)
#define SEAM(k) do { if (IN(k) && IN((k) + 1)) xcd_barrier(bar); } while (0)
    const int gw = blk * NWAVES + wave, NGW = G * NWAVES;

    if (IN(0)) {
        LAS float* scr = (LAS float*)(lds + wave * 16384);
        for (int it = gw; it < 1024 + 1024 + 256 + 1024; it += NGW) {
            int r = __builtin_amdgcn_readfirstlane(it);
            if (r < 1024) { p0_transpose_item(w_in, D, NP, g1, WinT, scr, r, lane); continue; } r -= 1024;
            if (r < 1024) { p0_transpose_item(w_q, D, NQ, g2, WqT, scr, r, lane); continue; } r -= 1024;
            if (r < 256) { p0_transpose_item(w_out, D, D, nullptr, WoutT, scr, r, lane); continue; } r -= 256;
            p0_weff_item(w_out, pool_w, pool_scale, WoutT, r, lane);
        }
        for (int m = gw; m < T; m += 4 * NGW) {
            f32x4 va[4], vb[4], vc[4], vd[4];
            row_load(x + (size_t)m * D, va, lane); row_load(x + (size_t)(m + NGW) * D, vb, lane); row_load(x + (size_t)(m + 2 * NGW) * D, vc, lane); row_load(x + (size_t)(m + 3 * NGW) * D, vd, lane);
            row_store_bf16(va, XB + (size_t)m * D, rstd1 + m, lane); row_store_bf16(vb, XB + (size_t)(m + NGW) * D, rstd1 + m + NGW, lane);
            row_store_bf16(vc, XB + (size_t)(m + 2 * NGW) * D, rstd1 + m + 2 * NGW, lane); row_store_bf16(vd, XB + (size_t)(m + 3 * NGW) * D, rstd1 + m + 3 * NGW, lane);
        }
        for (int m = gw; m < 256; m += NGW) row_to_bf16(keys + (size_t)m * D, KB + (size_t)m * D, nullptr, nullptr, lane);
    }
    SEAM(0); TSP(1);
    if (IN(1)) {
        for (int mb = blk; mb < 256; mb += G) p1_meta(meta, WinT, P, lds, mb, tid);
        pg8::Gemm g{XB, WinT, T, NP, D}; pg8::StaticOrder S; S.init(T, NP, G, blk);
        EpiP E{P, rstd1};
        pg8::gemm_phase<EpiP, pg8::StaticOrder, true, true>(lds, g, S, E);
    }
    SEAM(1); TSP(2);
    if (IN(2)) {
        for (int b2 = blk; b2 < T / 128; b2 += G) p2_convpool(P, conv_w, conv_b, YP, b2, tid);
    }
    SEAM(2); TSP(3);
    if (IN(3)) {
        pg8::Gemm g{YP, WoutT, T, D, D}; pg8::StaticOrder S; S.init(T, D, G, blk);
        EpiH2 E{x, H2B, rowss};
        pg8::gemm_phase<EpiH2, pg8::StaticOrder, true, true>(lds, g, S, E);
    }
    SEAM(3); TSP(4);
    if (IN(4)) {
        pg8::Gemm g{H2B, WqT, T, NQ, D}; pg8::StaticOrder S; S.init(T, NQ, G, blk);
        EpiQ E{Qb, rowss};
        pg8::gemm_phase<EpiQ, pg8::StaticOrder, true, true>(lds, g, S, E);
    }
    SEAM(4); TSP(5);
    if (IN(5)) {
        for (int vb = blk; vb < 256; vb += G) p5_block(Qb, KB, SI, SG, lds, vb, tid, pu, pv, g2, U8, V8, G);
    }
    SEAM(5); TSP(6);
    if (IN(6)) {
#ifdef PROBE_SEL
        t_p6start = __builtin_amdgcn_s_memrealtime();
#endif
        unsigned epoch = 0u; const unsigned nloc = MISC[8] ? MISC[8] : (unsigned)(G / 8);
        unsigned* xcnt = (unsigned*)(ws + WS_CTL) + CW_XS + 64 * xb_xcc_id();
        unsigned long long pt[6] = {0ull, 0ull, 0ull, 0ull, 0ull, 0ull};
        LAS unsigned char* stg = lds + wave * 16384;
        int pend_tok0 = -1;
        for (int t0 = gw * P6K; t0 < T; t0 += NGW * P6K) p6_round(H2B, rowss, SI, SG, U8, V8, gf, args.out, t0, lane, stg, pend_tok0, xcnt, nloc, epoch, pt);
        if (pend_tok0 >= 0) {
#pragma unroll 4
            for (int b = 0; b < 16; ++b) { const v4u d_ = *(const LAS v4u*)(stg + b * 1024 + lane * 16);
                *(v4u*)((char*)args.out + (size_t)pend_tok0 * (D * 4) + b * 1024 + lane * 16) = d_; } }
#if defined(PROBE_SEL) && PROBE_SEL != 9
        if (gw == 0 && lane == 0) { asm volatile("s_waitcnt vmcnt(0)" ::: "memory");
            const unsigned long long tend = __builtin_amdgcn_s_memrealtime();
            tsp[7] = tend;
            float us = (PROBE_SEL < 6) ? (float)pt[PROBE_SEL < 6 ? PROBE_SEL : 0] * 0.01f : ((PROBE_SEL == 6) ? (float)(tend - t_p6start) * 0.01f : ((PROBE_SEL == 7) ? (float)(tend - t_kstart) * 0.01f : (float)(tsp[(PROBE_SEL >= 10 ? PROBE_SEL - 10 : 0) + 1] - tsp[PROBE_SEL >= 10 ? PROBE_SEL - 10 : 0]) * 0.01f));
            args.out[0] = 2.0f + ((PROBE_SEL == 7) ? (us - 900.0f) : us) * 0.01f; }
#endif
    }
#if defined(PROBE_SEL) && PROBE_SEL == 9
    asm volatile("s_waitcnt vmcnt(0)" ::: "memory");
    if (tid == 0) atomicMax((unsigned long long*)(ws + WS_CTL + 72), (unsigned long long)__builtin_amdgcn_s_memrealtime());
    xcd_barrier(bar);
    if (blk == 0 && tid == 0) { const unsigned long long a = ~__hip_atomic_load((unsigned long long*)(ws + WS_CTL + 64), __ATOMIC_RELAXED, __HIP_MEMORY_SCOPE_AGENT), b = __hip_atomic_load((unsigned long long*)(ws + WS_CTL + 72), __ATOMIC_RELAXED, __HIP_MEMORY_SCOPE_AGENT);
        args.out[0] = 2.0f + ((float)(b - a) * 0.01f - 900.0f) * 0.01f; }
#endif
#undef IN
#undef SEAM
}

extern "C" void kernel_launch(void* const* d_in, const int* in_sizes, int n_in, void* d_out, int out_size, void* d_ws, size_t ws_size, hipStream_t stream) {
    static int grid = 0;
    if (grid == 0) {
        if (n_in != 15 || out_size != T * D || ws_size < WS_END) { fprintf(stderr, "kernel_launch: unexpected shapes: n_in %d out %d ws %zu (need %zu)\n", n_in, out_size, ws_size, (size_t)WS_END); grid = -1; return; }
        int dev = 0, cus = 0, per_cu = 0;
        if (hipGetDevice(&dev) != hipSuccess || hipDeviceGetAttribute(&cus, hipDeviceAttributeMultiprocessorCount, dev) != hipSuccess) { grid = -1; return; }
        if (hipFuncSetAttribute((const void*)fwd_kernel, hipFuncAttributeMaxDynamicSharedMemorySize, LDS_BYTES) != hipSuccess) { fprintf(stderr, "kernel_launch: hipFuncSetAttribute failed\n"); grid = -1; return; }
        if (hipOccupancyMaxActiveBlocksPerMultiprocessor(&per_cu, (const void*)fwd_kernel, NWAVES * 64, LDS_BYTES) != hipSuccess || per_cu < 1) fprintf(stderr, "kernel_launch: occupancy query says %d\n", per_cu);
        (void)hipGetLastError();
        grid = cus;
        if (grid != 256) { fprintf(stderr, "kernel_launch: built for a 256-CU device (work is dealt to 256 workgroups x 8 waves); found %d CUs\n", cus); grid = -1; return; }
    }
    if (grid < 0) return;
    (void)hipMemsetAsync((char*)d_ws + WS_CTL, 0, CTL_ZERO_BYTES, stream);
    Args a{};
    for (int i = 0; i < 15; ++i) a.in[i] = (const float*)d_in[i];
    a.out = (float*)d_out; a.ws = (unsigned char*)d_ws;
#if MK_N_LAUNCHES == 1
    a.ph_lo = 0; a.ph_hi = NPHASE;
    hipLaunchKernelGGL(fwd_kernel, dim3(grid), dim3(NWAVES * 64), LDS_BYTES, stream, a);
#else
    for (int li = 0; li < NPHASE; ++li) { a.ph_lo = li; a.ph_hi = li + 1;
        hipLaunchKernelGGL(fwd_kernel, dim3(grid), dim3(NWAVES * 64), LDS_BYTES, stream, a); }
#endif
}
```

```cpp
#include <hip/hip_runtime.h>
#include <cstdio>
#include <cstdint>
namespace pg8 {
#define PG8_LAS __attribute__((address_space(3)))
typedef unsigned short bf16_t;
typedef short bf16x8 __attribute__((ext_vector_type(8)));
typedef float f32x4 __attribute__((ext_vector_type(4)));
typedef unsigned u32x4 __attribute__((ext_vector_type(4)));
constexpr int BM = 256, BK = 64, HALF = 128, HTB = HALF * BK * 2  , STAGE_BYTES = 8 * HTB, NXCD = 8, WGM = 8;

__host__ __device__ __forceinline__ int lds_byte(int r, int c) { const int st = (r >> 4) * 2 + (c >> 5), rr = r & 15, cc = c & 31, ob = rr * 64 + cc * 2; return st * 1024 + (ob ^ (((ob >> 9) & 1) << 5)); }
__host__ __device__ __forceinline__ void stage_rc(int b, int& R, int& C) { const int st = b / 1024, sb = b % 1024, swz = sb ^ (((sb >> 9) & 1) << 5); R = (st >> 1) * 16 + swz / 64; C = (st & 1) * 32 + (swz % 64) / 2; }
__host__ __device__ __forceinline__ int perm32(int rho) { const int n = rho >> 4, i = rho & 15; return 8 * (i >> 2) + 4 * n + (i & 3); }

struct Unit { int pm, pn; };
struct Gemm { const bf16_t* A; const bf16_t* Bt; int M, N, K; };

struct StaticOrder {
    int nM, nN, nwg, G, c;
    __host__ __device__ void init(int M, int N, int G_, int c_) { nM = M / BM; nN = N / BM; nwg = nM * nN; G = G_; c = c_; }
    __host__ __device__ bool next(int i, Unit& u) const {
        const long L = (long)i * G + c; if (L >= nwg) return false;
        int wgid = (int)L; { const int q = nwg / NXCD, r = nwg % NXCD, xcd = wgid % NXCD, off = wgid / NXCD; wgid = (xcd < r ? xcd * (q + 1) : r * (q + 1) + (xcd - r) * q) + off; }
        const int nig = WGM * nN, gid = wgid / nig, fm = gid * WGM, gsz = (nM - fm) < WGM ? (nM - fm) : WGM;
        u.pm = fm + ((wgid % nig) % gsz); u.pn = (wgid % nig) / gsz; return true;
    }
    __device__ __forceinline__ void a_ready(const Unit&) const {}
    __device__ __forceinline__ void done(const Unit&) const {}
};

__device__ __forceinline__ unsigned cvt_pk_bf16(float lo, float hi) { unsigned r; asm volatile("v_cvt_pk_bf16_f32 %0, %1, %2" : "=v"(r) : "v"(lo), "v"(hi)); return r; }
template <class Epi, class Sched, bool ALIGN_EPI = false, bool SP2 = false>
__device__ __forceinline__ void gemm_phase(PG8_LAS unsigned char* lds, const Gemm g, const Sched& S, const Epi& E) {
    const int tid = threadIdx.x, wid = __builtin_amdgcn_readfirstlane(tid >> 6), lane = tid & 63, wr = wid >> 2, wc = wid & 3, fr = lane & 15, fq = lane >> 4;
    const int K = g.K, nt = K / BK;
    unsigned voffA[2], voffB[2];
#pragma unroll
    for (int i = 0; i < 2; ++i) { int R, C; stage_rc(tid * 16 + i * 8192, R, C); const int Rb = Epi::PERM ? ((R & ~31) + perm32(R & 31)) : R;
        voffA[i] = (unsigned)(R * K + C) * 2u; voffB[i] = (unsigned)(Rb * K + C) * 2u; }
    const size_t kstep = (size_t)(BK * 2);
    const size_t hstep = (size_t)HALF * K * 2;
    const size_t tstep = 2 * hstep;
    const unsigned ldsw = (unsigned)wid * 1024u;
    const int aoff = lds_byte(wr * 64 + fr, fq * 8), boff = lds_byte(wc * 32 + fr, fq * 8);
#define PG8_SA(b, h) (((b) * 2 + (h)) * HTB)
#define PG8_SB(b, h) ((4 + (b) * 2 + (h)) * HTB)
#define PG8_STAGE(bufoff, gbase, voff) do { _Pragma("unroll") for (int _i = 0; _i < 2; ++_i) \
        __builtin_amdgcn_global_load_lds((const unsigned*)((const char*)(gbase) + (voff)[_i]), (PG8_LAS unsigned*)(lds + (bufoff) + ldsw + _i * 8192), 16, 0, 0); } while (0)
#define PG8_LDA(dst, b, h) do { _Pragma("unroll") for (int m = 0; m < 4; ++m) _Pragma("unroll") for (int k = 0; k < 2; ++k) dst[m][k] = *(const PG8_LAS bf16x8*)(lds + PG8_SA(b, h) + aoff + m * 2048 + k * 1024); } while (0)
#define PG8_LDB(dst, b, h) do { _Pragma("unroll") for (int n = 0; n < 2; ++n) _Pragma("unroll") for (int k = 0; k < 2; ++k) dst[n][k] = *(const PG8_LAS bf16x8*)(lds + PG8_SB(b, h) + boff + n * 2048 + k * 1024); } while (0)
#define PG8_MMA(ai, bj, At, Bt) do { __builtin_amdgcn_s_setprio(1); _Pragma("unroll") for (int m = 0; m < 4; ++m) _Pragma("unroll") for (int n = 0; n < 2; ++n) _Pragma("unroll") for (int k = 0; k < 2; ++k) \
        acc[ai][bj][m][n] = __builtin_amdgcn_mfma_f32_16x16x32_bf16(Bt[n][k], At[m][k], acc[ai][bj][m][n], 0, 0, 0); __builtin_amdgcn_s_setprio(0); } while (0)
#define PG8_WAIT_V(n) asm volatile("s_waitcnt vmcnt(" #n ")" ::: "memory")
#define PG8_WAIT_L(n) asm volatile("s_waitcnt lgkmcnt(" #n ")" ::: "memory")
#define PG8_BAR __builtin_amdgcn_s_barrier()
#define PG8_SCHED __builtin_amdgcn_sched_barrier(0)
    Unit cur, nxt; int ui = 0;
    if (!S.next(0, cur)) return;
    f32x4 acc[2][2][4][2];
#pragma unroll
    for (int a = 0; a < 2; ++a)
#pragma unroll
        for (int b = 0; b < 2; ++b)
#pragma unroll
            for (int m = 0; m < 4; ++m)
#pragma unroll
                for (int n = 0; n < 2; ++n) acc[a][b][m][n] = (f32x4){0.f, 0.f, 0.f, 0.f};
    bf16x8 At[4][2], B0[2][2], B1[2][2];
    const char* cA = (const char*)g.A + (size_t)cur.pm * tstep; const char* cB = (const char*)g.Bt + (size_t)cur.pn * tstep;
    S.a_ready(cur);
    if constexpr (SP2) {
        PG8_STAGE(PG8_SB(0, 0), cB, voffB); PG8_STAGE(PG8_SB(0, 1), cB + hstep, voffB); PG8_STAGE(PG8_SA(0, 0), cA, voffA); PG8_STAGE(PG8_SA(0, 1), cA + hstep, voffA);
        if (wr == 1) PG8_BAR;
        PG8_WAIT_V(2); PG8_BAR;
        PG8_STAGE(PG8_SB(1, 0), cB + kstep, voffB); PG8_STAGE(PG8_SA(1, 0), cA + kstep, voffA); PG8_STAGE(PG8_SB(1, 1), cB + hstep + kstep, voffB);
        PG8_WAIT_V(6); PG8_BAR;
    } else {
        PG8_STAGE(PG8_SB(0, 0), cB, voffB); PG8_STAGE(PG8_SA(0, 0), cA, voffA); PG8_STAGE(PG8_SB(0, 1), cB + hstep, voffB); PG8_STAGE(PG8_SA(0, 1), cA + hstep, voffA);
        if (wr == 1) PG8_BAR;
        PG8_WAIT_V(4); PG8_BAR;
        PG8_STAGE(PG8_SB(1, 0), cB + kstep, voffB); PG8_STAGE(PG8_SA(1, 0), cA + kstep, voffA); PG8_STAGE(PG8_SB(1, 1), cB + hstep + kstep, voffB);
        PG8_WAIT_V(6); PG8_BAR;
    }
    for (;;) {
        const bool has_next = S.next(ui + 1, nxt);
        const char* nA = has_next ? (const char*)g.A + (size_t)nxt.pm * tstep : cA; const char* nB = has_next ? (const char*)g.Bt + (size_t)nxt.pn * tstep : cB;
        for (int t = 0; t < nt; t += 2) {
            const bool last = (t == nt - 2);
            const char* a1 = cA + (size_t)(t + 1) * kstep;
            const char* a2 = last ? nA : cA + (size_t)(t + 2) * kstep; const char* b2 = last ? nB : cB + (size_t)(t + 2) * kstep;
            const char* a3 = a2 + kstep; const char* b3 = b2 + kstep;
            if (last && has_next) S.a_ready(nxt);
            if constexpr (SP2) {
            PG8_LDB(B0, 0, 0); PG8_LDB(B1, 0, 1); PG8_SCHED; PG8_LDA(At, 0, 0); PG8_STAGE(PG8_SA(1, 1), a1 + hstep, voffA);
            PG8_WAIT_V(8); PG8_WAIT_L(0); PG8_BAR; PG8_MMA(0, 0, At, B0); PG8_MMA(0, 1, At, B1); PG8_BAR; PG8_SCHED;
            PG8_LDA(At, 0, 1); PG8_STAGE(PG8_SB(0, 0), b2, voffB); PG8_STAGE(PG8_SB(0, 1), b2 + hstep, voffB); PG8_STAGE(PG8_SA(0, 0), a2, voffA);
            PG8_WAIT_V(8); PG8_WAIT_L(0); PG8_BAR; PG8_MMA(1, 0, At, B0); PG8_MMA(1, 1, At, B1); PG8_BAR; PG8_SCHED;
            PG8_LDB(B0, 1, 0); PG8_LDB(B1, 1, 1); PG8_SCHED; PG8_LDA(At, 1, 0); PG8_STAGE(PG8_SA(0, 1), a2 + hstep, voffA);
            PG8_WAIT_V(8); PG8_WAIT_L(0); PG8_BAR; PG8_MMA(0, 0, At, B0); PG8_MMA(0, 1, At, B1); PG8_BAR; PG8_SCHED;
            PG8_LDA(At, 1, 1); PG8_STAGE(PG8_SB(1, 0), b3, voffB); PG8_STAGE(PG8_SB(1, 1), b3 + hstep, voffB); PG8_STAGE(PG8_SA(1, 0), a3, voffA);
            PG8_WAIT_V(8); PG8_WAIT_L(0); PG8_BAR; PG8_MMA(1, 0, At, B0); PG8_MMA(1, 1, At, B1); PG8_BAR; PG8_SCHED;
            } else {
            PG8_LDB(B0, 0, 0); PG8_SCHED; PG8_LDA(At, 0, 0); PG8_STAGE(PG8_SA(1, 1), a1 + hstep, voffA);
            PG8_WAIT_L(8); PG8_BAR; PG8_WAIT_L(0); PG8_MMA(0, 0, At, B0); PG8_BAR; PG8_SCHED;
            PG8_LDB(B1, 0, 1); PG8_STAGE(PG8_SB(0, 0), b2, voffB);
            PG8_BAR; PG8_WAIT_L(0); PG8_MMA(0, 1, At, B1); PG8_BAR;
            PG8_LDA(At, 0, 1); PG8_STAGE(PG8_SA(0, 0), a2, voffA);
            PG8_BAR; PG8_WAIT_L(0); PG8_MMA(1, 0, At, B0); PG8_BAR; PG8_SCHED;
            PG8_STAGE(PG8_SB(0, 1), b2 + hstep, voffB);
            PG8_WAIT_V(6); PG8_BAR; PG8_MMA(1, 1, At, B1); PG8_BAR;
            PG8_LDB(B0, 1, 0); PG8_SCHED; PG8_LDA(At, 1, 0); PG8_STAGE(PG8_SA(0, 1), a2 + hstep, voffA);
            PG8_WAIT_L(8); PG8_BAR; PG8_WAIT_L(0); PG8_MMA(0, 0, At, B0); PG8_BAR; PG8_SCHED;
            PG8_LDB(B1, 1, 1); PG8_STAGE(PG8_SB(1, 0), b3, voffB);
            PG8_BAR; PG8_WAIT_L(0); PG8_MMA(0, 1, At, B1); PG8_BAR;
            PG8_LDA(At, 1, 1); PG8_STAGE(PG8_SA(1, 0), a3, voffA);
            PG8_BAR; PG8_WAIT_L(0); PG8_MMA(1, 0, At, B0); PG8_BAR; PG8_SCHED;
            PG8_STAGE(PG8_SB(1, 1), b3 + hstep, voffB);
            PG8_WAIT_V(6); PG8_BAR; PG8_MMA(1, 1, At, B1); PG8_BAR;
            }
        }
        if constexpr (ALIGN_EPI) { if (wr == 0) PG8_BAR; }
        if constexpr (!Epi::AFTER_DRAIN) { E(acc, cur, wr, wc, fr, fq); S.done(cur); }
        if (!has_next) break;
#pragma unroll
        for (int a = 0; a < 2; ++a)
#pragma unroll
            for (int b = 0; b < 2; ++b)
#pragma unroll
                for (int m = 0; m < 4; ++m)
#pragma unroll
                    for (int n = 0; n < 2; ++n) acc[a][b][m][n] = (f32x4){0.f, 0.f, 0.f, 0.f};
        cur = nxt; cA = nA; cB = nB; ++ui;
        if constexpr (ALIGN_EPI) { if (wr == 1) PG8_BAR; }
    }
    PG8_WAIT_V(0);
    if constexpr (!ALIGN_EPI) { if (wr == 0) PG8_BAR; }
    PG8_BAR;
    if constexpr (Epi::AFTER_DRAIN) { E.fused(acc, cur, wr, wc, fr, fq, lds, wid, lane); S.done(cur); }
#undef PG8_SA
#undef PG8_SB
#undef PG8_STAGE
#undef PG8_LDA
#undef PG8_LDB
#undef PG8_MMA
#undef PG8_WAIT_V
#undef PG8_WAIT_L
#undef PG8_BAR
#undef PG8_SCHED
}
}

#define GAS __attribute__((address_space(1)))
#define LAS __attribute__((address_space(3)))
#define XB_TMO      128
#define XB_XCNT(j)  (256  + 64 * (j))
#define XB_XSUB(j)  (1280 + 64 * (j))
#define XB_XGEN(j)  (2304 + 64 * (j))
#define XB_TOP      3328
#define XB_TOPGEN   3392
#define XCD_BAR_WORDS 3456
#define XB_SPIN_CAP (1u << 18)

__device__ __forceinline__ unsigned xb_ld(unsigned* p)              { return __hip_atomic_load(p, __ATOMIC_RELAXED, __HIP_MEMORY_SCOPE_AGENT); }
__device__ __forceinline__ unsigned xb_add(unsigned* p, unsigned v) { return __hip_atomic_fetch_add(p, v, __ATOMIC_RELAXED, __HIP_MEMORY_SCOPE_AGENT); }
__device__ __forceinline__ unsigned xb_xcc_id() { return (unsigned)__builtin_amdgcn_s_getreg((3 << 11) | 20) & 0xFu; }
#define XB_SPIN(cond, bar) do { unsigned _sp = 0; while (cond) { __builtin_amdgcn_s_sleep(1); \
    if ((++_sp & 255u) == 0u) { if (xb_ld(&(bar)[XB_TMO])) break; if (_sp > XB_SPIN_CAP) { atomicAdd(&(bar)[XB_TMO], 1u); break; } } } } while (0)

struct XcdBarrier {
    unsigned* bar; unsigned x;
    volatile LAS unsigned* st;
};

__device__ __forceinline__ XcdBarrier xcd_barrier_post(unsigned* bar, volatile LAS unsigned* st) {
    XcdBarrier b; b.bar = bar; b.x = xb_xcc_id(); b.st = st;
    if (threadIdx.x == 0) (void)xb_add(&bar[XB_XCNT(b.x)], 1u);
    return b;
}
__device__ __forceinline__ void xcd_barrier_complete(unsigned* bar, unsigned x, unsigned& nloc, unsigned& nx) {
    const unsigned G = gridDim.x * gridDim.y * gridDim.z;
    unsigned sum, cnt, mine, sp = 0u;
    for (;;) {
        sum = 0u; cnt = 0u; mine = 0u;
#pragma unroll
        for (unsigned j = 0; j < 16; ++j) { const unsigned c = xb_ld(&bar[XB_XCNT(j)]); sum += c; cnt += (c > 0u) ? 1u : 0u; mine = (j == x) ? c : mine; }
        if (sum == G) break;
        __builtin_amdgcn_s_sleep(1);
        if ((++sp & 255u) == 0u) { if (xb_ld(&bar[XB_TMO])) break; if (sp > XB_SPIN_CAP) { atomicAdd(&bar[XB_TMO], 1u); break; } }
    }
    nloc = mine > 0u ? mine : 1u; nx = cnt > 0u ? cnt : 1u;
}

__device__ __forceinline__ void xcd_barrier(const XcdBarrier& b) {
    asm volatile("s_waitcnt vmcnt(0)" ::: "memory");
    __syncthreads();
    if (threadIdx.x == 0) {
        unsigned* bar = b.bar;
        __builtin_amdgcn_s_waitcnt(0);
        unsigned nloc = b.st[0], nx = b.st[1];
        if (nloc == 0u) { xcd_barrier_complete(bar, b.x, nloc, nx); b.st[0] = nloc; b.st[1] = nx; }
        const unsigned old = xb_add(&bar[XB_XSUB(b.x)], 1u);
        const unsigned gen = old / nloc;
        if (old + 1u == (gen + 1u) * nloc) {
            __builtin_amdgcn_fence(__ATOMIC_RELEASE, "agent");
            asm volatile("s_waitcnt vmcnt(0)" ::: "memory");
            const unsigned og = xb_add(&bar[XB_TOP], 1u);
            const unsigned tg = og / nx;
            if (og + 1u == (tg + 1u) * nx) xb_add(&bar[XB_TOPGEN], 1u);
            else XB_SPIN(xb_ld(&bar[XB_TOPGEN]) == tg, bar);
            __builtin_amdgcn_fence(__ATOMIC_ACQUIRE, "agent");
            xb_add(&bar[XB_XGEN(b.x)], 1u);
            asm volatile("s_waitcnt vmcnt(0)" ::: "memory");
        } else {
            XB_SPIN(xb_ld(&bar[XB_XGEN(b.x)]) == gen, bar);
            __builtin_amdgcn_fence(__ATOMIC_ACQUIRE, "agent");
            asm volatile("s_waitcnt vmcnt(0)" ::: "memory");
        }
    }
    __syncthreads();
}

constexpr int D = 1024, BATCH = 4, SEQ = 8192, NMETA = 16, LSEQ = SEQ + NMETA;
constexpr int T = BATCH * SEQ;
constexpr int NP = 2048, NQ = 2048, NEXP = 16384;
constexpr float EPS = 1e-6f;
constexpr int NWAVES = 8;

constexpr size_t MiB = 1u << 20;
constexpr size_t WS_CTL = 0, CTL_ZERO_BYTES = 1 * MiB;
constexpr int CW_BAR = 4096, CW_XS = 8192;
constexpr size_t WS_ROWSS = 512 * 1024;
constexpr size_t WS_WIN = 2 * MiB, WS_WOUT = 6 * MiB, WS_WQ = 8 * MiB, WS_KEYS = 12 * MiB, WS_RSTD1 = 13 * MiB;
constexpr size_t WS_UB = 16 * MiB  , WS_VB = 48 * MiB  , WS_XB = 80 * MiB  , WS_P = 144 * MiB  ;
constexpr size_t WS_H2B = 274 * MiB, WS_SELI = 338 * MiB, WS_SELG = 354 * MiB, WS_END = 370 * MiB;

constexpr int RING_BYTES = 131072, MISC_OFF = RING_BYTES + 320, LDS_BYTES = 147456;

typedef unsigned short bf16;
typedef unsigned v4u __attribute__((ext_vector_type(4)));
typedef unsigned v2u __attribute__((ext_vector_type(2)));
typedef float f32x4 __attribute__((ext_vector_type(4)));
typedef float f32x16 __attribute__((ext_vector_type(16)));
typedef short bf16x8 __attribute__((ext_vector_type(8)));
typedef __bf16 bf16x2_t __attribute__((ext_vector_type(2)));
#define LDS_WAIT() asm volatile("s_waitcnt lgkmcnt(0)" ::: "memory")

__device__ __forceinline__ unsigned f2bf(float f) { unsigned u = __builtin_bit_cast(unsigned, f); return (u + 0x7fffu + ((u >> 16) & 1u)) >> 16; }
__device__ __forceinline__ unsigned pk2(float lo, float hi) { return f2bf(lo) | (f2bf(hi) << 16); }
__device__ __forceinline__ float bflo(unsigned w) { return __builtin_bit_cast(float, w << 16); }
__device__ __forceinline__ float bfhi(unsigned w) { return __builtin_bit_cast(float, w & 0xffff0000u); }
__device__ __forceinline__ float wave_sum(float v) {
#pragma unroll
    for (int o = 1; o < 64; o <<= 1) v += __shfl_xor(v, o);
    return v;
}

struct EpiP {
    static constexpr bool PERM = true, AFTER_DRAIN = false;
    bf16* P; const float* rstd;
    __device__ __forceinline__ void operator()(const pg8::f32x4 (&acc)[2][2][4][2], const pg8::Unit& u, int wr, int wc, int fr, int fq) const {
        const int row0 = u.pm * 256 + wr * 64 + fr, col0 = u.pn * 256 + wc * 32 + 8 * fq;
#pragma unroll
        for (int ai = 0; ai < 2; ++ai)
#pragma unroll
            for (int m = 0; m < 4; ++m) {
                const int row = row0 + ai * 128 + m * 16; const float rs = rstd[row];
                bf16* rowp = P + ((size_t)(row >> 13) * LSEQ + NMETA + (row & 8191)) * NP + col0;
#pragma unroll
                for (int bj = 0; bj < 2; ++bj) { const pg8::f32x4 v0 = acc[ai][bj][m][0] * rs, v1 = acc[ai][bj][m][1] * rs;
                    v4u w; w.x = pg8::cvt_pk_bf16(v0[0], v0[1]); w.y = pg8::cvt_pk_bf16(v0[2], v0[3]); w.z = pg8::cvt_pk_bf16(v1[0], v1[1]); w.w = pg8::cvt_pk_bf16(v1[2], v1[3]);
                    *(v4u*)(rowp + bj * 128) = w; }
            }
    }
};
struct EpiH2 {
    static constexpr bool PERM = true, AFTER_DRAIN = false;
    const float* X; bf16* H2B; unsigned long long* rowss;
    __device__ __forceinline__ void operator()(const pg8::f32x4 (&acc)[2][2][4][2], const pg8::Unit& u, int wr, int wc, int fr, int fq) const {
        const int row0 = u.pm * 256 + wr * 64 + fr, col0 = u.pn * 256 + wc * 32 + 8 * fq;
#pragma unroll
        for (int ai = 0; ai < 2; ++ai)
#pragma unroll
            for (int m = 0; m < 4; ++m) {
                const int row = row0 + ai * 128 + m * 16; const size_t off = (size_t)row * D + col0; float ss = 0.f;
#pragma unroll
                for (int bj = 0; bj < 2; ++bj) {
                    const pg8::f32x4 x0 = *(const pg8::f32x4*)(X + off + bj * 128), x1 = *(const pg8::f32x4*)(X + off + bj * 128 + 4);
                    const pg8::f32x4 v0 = acc[ai][bj][m][0] + x0, v1 = acc[ai][bj][m][1] + x1;
                    v4u w; w.x = pg8::cvt_pk_bf16(v0[0], v0[1]); w.y = pg8::cvt_pk_bf16(v0[2], v0[3]); w.z = pg8::cvt_pk_bf16(v1[0], v1[1]); w.w = pg8::cvt_pk_bf16(v1[2], v1[3]);
                    *(v4u*)(H2B + off + bj * 128) = w;
                    ss += (v0[0] * v0[0] + v0[1] * v0[1]) + (v0[2] * v0[2] + v0[3] * v0[3]) + (v1[0] * v1[0] + v1[1] * v1[1]) + (v1[2] * v1[2] + v1[3] * v1[3]);
                }
                ss += __shfl_xor(ss, 16); ss += __shfl_xor(ss, 32);
                if (fq == 0) atomicAdd(rowss + row, (unsigned long long)(ss * 4294967296.0f));
            }
    }
};
struct EpiQ {
    static constexpr bool PERM = true, AFTER_DRAIN = false;
    bf16* Q; const unsigned long long* rowss;
    __device__ __forceinline__ void operator()(const pg8::f32x4 (&acc)[2][2][4][2], const pg8::Unit& u, int wr, int wc, int fr, int fq) const {
        const int row0 = u.pm * 256 + wr * 64 + fr, col0 = u.pn * 256 + wc * 32 + 8 * fq;
#pragma unroll
        for (int ai = 0; ai < 2; ++ai)
#pragma unroll
            for (int m = 0; m < 4; ++m) {
                const int row = row0 + ai * 128 + m * 16; const float rs = rsqrtf((float)rowss[row] * (1.0f / (4294967296.0f * D)) + EPS);
                bf16* rowp = Q + (size_t)row * NQ + col0;
#pragma unroll
                for (int bj = 0; bj < 2; ++bj) { const pg8::f32x4 v0 = acc[ai][bj][m][0] * rs, v1 = acc[ai][bj][m][1] * rs;
                    v4u w; w.x = pg8::cvt_pk_bf16(v0[0], v0[1]); w.y = pg8::cvt_pk_bf16(v0[2], v0[3]); w.z = pg8::cvt_pk_bf16(v1[0], v1[1]); w.w = pg8::cvt_pk_bf16(v1[2], v1[3]);
                    *(v4u*)(rowp + bj * 128) = w; }
            }
    }
};

__device__ __forceinline__ void row_to_bf16(const float* src, bf16* dst, const float* gain, float* rstd_out, int lane) {
    const f32x4* xr = (const f32x4*)src + lane;
    f32x4 v[4]; float s = 0.f;
#pragma unroll
    for (int j = 0; j < 4; ++j) { v[j] = xr[64 * j]; s += (v[j].x * v[j].x + v[j].y * v[j].y) + (v[j].z * v[j].z + v[j].w * v[j].w); }
    if (rstd_out) { s = wave_sum(s); if (lane == 0) *rstd_out = rsqrtf(s * (1.0f / D) + EPS); }
    if (gain) {
#pragma unroll
        for (int j = 0; j < 4; ++j) v[j] = v[j] * ((const f32x4*)gain)[lane + 64 * j];
    }
    unsigned long long* o8 = (unsigned long long*)dst + lane;
#pragma unroll
    for (int j = 0; j < 4; ++j) o8[64 * j] = (unsigned long long)pk2(v[j].x, v[j].y) | ((unsigned long long)pk2(v[j].z, v[j].w) << 32);
}
typedef float f32x2 __attribute__((ext_vector_type(2)));
constexpr float U8_SCALE = 64.0f, V8_SCALE = 8.0f;
__device__ __forceinline__ void row_to_fp8(const float* src, unsigned char* dst, const float* gain, float scale, int lane) {
    const f32x4* xr = (const f32x4*)src + lane;
    unsigned* o = (unsigned*)dst + lane;
#pragma unroll
    for (int j = 0; j < 4; ++j) { f32x4 v = xr[64 * j]; if (gain) v = v * ((const f32x4*)gain)[lane + 64 * j]; v = v * scale;
        int pk = 0; pk = __builtin_amdgcn_cvt_pk_fp8_f32(v.x, v.y, pk, false); pk = __builtin_amdgcn_cvt_pk_fp8_f32(v.z, v.w, pk, true);
        o[64 * j] = (unsigned)pk; }
}
__device__ __forceinline__ void row_load(const float* src, f32x4 (&v)[4], int lane) {
    const f32x4* xr = (const f32x4*)src + lane;
#pragma unroll
    for (int j = 0; j < 4; ++j) v[j] = __builtin_nontemporal_load(xr + 64 * j);
}
__device__ __forceinline__ void row_store_bf16(const f32x4 (&v)[4], bf16* dst, float* rstd_out, int lane) {
    float s = 0.f;
#pragma unroll
    for (int j = 0; j < 4; ++j) s += (v[j].x * v[j].x + v[j].y * v[j].y) + (v[j].z * v[j].z + v[j].w * v[j].w);
    if (rstd_out) { s = wave_sum(s); if (lane == 0) *rstd_out = rsqrtf(s * (1.0f / D) + EPS); }
    unsigned long long* o8 = (unsigned long long*)dst + lane;
#pragma unroll
    for (int j = 0; j < 4; ++j) o8[64 * j] = (unsigned long long)pk2(v[j].x, v[j].y) | ((unsigned long long)pk2(v[j].z, v[j].w) << 32);
}
__device__ __forceinline__ void row_store_fp8(const f32x4 (&v)[4], unsigned char* dst, const f32x4 (&gn)[4], float scale, int lane) {
    unsigned* o = (unsigned*)dst + lane;
#pragma unroll
    for (int j = 0; j < 4; ++j) { const f32x4 w = v[j] * gn[j] * scale;
        int pk = 0; pk = __builtin_amdgcn_cvt_pk_fp8_f32(w.x, w.y, pk, false); pk = __builtin_amdgcn_cvt_pk_fp8_f32(w.z, w.w, pk, true);
        o[64 * j] = (unsigned)pk; }
}
__device__ __forceinline__ void p0_transpose_item(const float* W, int K, int N, const float* gain, bf16* WT, LAS float* scr, int item, int lane) {
    const int nblk = N / 32, kb = item / nblk, nb = item % nblk, k0 = 64 * kb, n0 = 32 * nb;
    float tv_[32];
#pragma unroll
    for (int i = 0; i < 32; ++i) { const int kk = 2 * i + (lane >> 5); tv_[i] = W[(size_t)(k0 + kk) * N + n0 + (lane & 31)]; }
#pragma unroll
    for (int i = 0; i < 32; ++i) { const int kk = 2 * i + (lane >> 5); const float gk = gain ? gain[k0 + kk] : 1.0f; scr[kk * 33 + (lane & 31)] = tv_[i] * gk; }
    LDS_WAIT(); asm volatile("" ::: "memory");
    const int c = lane & 7;
#pragma unroll
    for (int j = 0; j < 4; ++j) { const int n = (lane >> 3) + 8 * j; const LAS float* s = scr + (8 * c) * 33 + n;
        v4u o; o.x = pk2(s[0 * 33], s[1 * 33]); o.y = pk2(s[2 * 33], s[3 * 33]); o.z = pk2(s[4 * 33], s[5 * 33]); o.w = pk2(s[6 * 33], s[7 * 33]);
        *(v4u*)(WT + (size_t)(n0 + n) * K + k0 + 8 * c) = o; }
    LDS_WAIT(); asm volatile("" ::: "memory");
}
__device__ __forceinline__ void p0_weff_item(const float* w_out, const float* pool_w, const float* pool_scale, bf16* WoutT, int item, int lane) {
    const int nb = item & 15, cg = (item >> 4) & 15, g = item >> 8;
    const int n = nb * 64 + lane;
    float acc[8];
#pragma unroll
    for (int i = 0; i < 8; ++i) acc[i] = 0.f;
    const float* wo = w_out + (size_t)(512 + g * 128) * D + n;
    const float* pw = pool_w + (size_t)(g * 128 + cg * 8) * 128;
    float pwr[8][2];
#pragma unroll
    for (int h = 0; h < 2; ++h) { const float psv = pool_scale[g * 128 + 64 * h + lane];
#pragma unroll
        for (int i = 0; i < 8; ++i) pwr[i][h] = pw[i * 128 + 64 * h + lane] * psv; }
#pragma unroll
    for (int h = 0; h < 2; ++h)
        for (int d0 = 0; d0 < 64; d0 += 32) { float wl_[32];
#pragma unroll
            for (int dd = 0; dd < 32; ++dd) wl_[dd] = wo[(size_t)(64 * h + d0 + dd) * D];
#pragma unroll
            for (int dd = 0; dd < 32; ++dd)
#pragma unroll
                for (int i = 0; i < 8; ++i) acc[i] += __builtin_bit_cast(float, __builtin_amdgcn_readlane(__builtin_bit_cast(int, pwr[i][h]), d0 + dd)) * wl_[dd]; }
    v4u o; o.x = pk2(acc[0], acc[1]); o.y = pk2(acc[2], acc[3]); o.z = pk2(acc[4], acc[5]); o.w = pk2(acc[6], acc[7]);
    *(v4u*)(WoutT + (size_t)n * D + 512 + g * 128 + cg * 8) = o;
}
__device__ __forceinline__ void p1_meta(const float* meta, const bf16* WinT, bf16* P, LAS unsigned char* lds, int blk, int tid) {
    LAS unsigned* mbw = (LAS unsigned*)lds;
    LAS float* rs = (LAS float*)(lds + 32768);
    const int wave = tid >> 6, lane = tid & 63;
    for (int i = tid; i < 16 * 512; i += 512) { const float lo = meta[2 * i], hi = meta[2 * i + 1]; mbw[i] = pk2(lo, hi); }
#pragma unroll
    for (int jj = 0; jj < 2; ++jj) { const int j = wave * 2 + jj; float s = 0.f;
        for (int k = lane; k < 1024; k += 64) { const float v = meta[j * 1024 + k]; s += v * v; }
        s = wave_sum(s); if (lane == 0) rs[j] = rsqrtf(s * (1.0f / D) + EPS); }
    __syncthreads();
    const int n = 8 * blk + wave;
    const v4u* wp = (const v4u*)(WinT + (size_t)n * D) + 2 * lane;
    const v4u wa = wp[0], wb = wp[1];
    const unsigned ww[8] = {wa.x, wa.y, wa.z, wa.w, wb.x, wb.y, wb.z, wb.w};
    float mine = 0.f;
#pragma unroll
    for (int j = 0; j < 16; ++j) {
        const v4u ma = *(const LAS v4u*)(lds + j * 2048 + lane * 32), mc = *(const LAS v4u*)(lds + j * 2048 + lane * 32 + 16);
        const unsigned mw[8] = {ma.x, ma.y, ma.z, ma.w, mc.x, mc.y, mc.z, mc.w};
        float d = 0.f;
#pragma unroll
        for (int q = 0; q < 8; ++q) d = __builtin_amdgcn_fdot2_f32_bf16(__builtin_bit_cast(bf16x2_t, ww[q]), __builtin_bit_cast(bf16x2_t, mw[q]), d, false);
        d = wave_sum(d);
        mine = (lane == j) ? d : mine;
    }
    if (lane < 16) { const bf16 o = (bf16)f2bf(mine * rs[lane]);
#pragma unroll
        for (int b = 0; b < BATCH; ++b) P[((size_t)b * LSEQ + lane) * NP + n] = o; }
    __syncthreads();
}

__device__ __forceinline__ void ld8(const bf16* p, float (&f)[8]) {
    const v4u w = *(const v4u*)p;
    f[0] = bflo(w.x); f[1] = bfhi(w.x); f[2] = bflo(w.y); f[3] = bfhi(w.y); f[4] = bflo(w.z); f[5] = bfhi(w.z); f[6] = bflo(w.w); f[7] = bfhi(w.w);
}
__device__ __forceinline__ void st8(bf16* p, const float (&f)[8]) {
    v4u o; o.x = pk2(f[0], f[1]); o.y = pk2(f[2], f[3]); o.z = pk2(f[4], f[5]); o.w = pk2(f[6], f[7]); *(v4u*)p = o;
}
__device__ __forceinline__ void p2_convpool(const bf16* __restrict__ P, const float* __restrict__ conv_w, const float* __restrict__ conv_b, bf16* __restrict__ Y, int blk, int tid) {
    const int cgp = tid & 127, run = tid >> 7;
    const int r_start = blk * 128 + run * 32;
    const int b = r_start >> 13, l0 = NMETA + (r_start & 8191);
    const bf16* Pb = P + (size_t)b * LSEQ * NP;
    if (cgp < 64) {
        const int c0 = cgp * 8;
        float w0[8], w1[8], w2[8], cb[8];
#pragma unroll
        for (int i = 0; i < 8; ++i) { w0[i] = conv_w[c0 + i]; w1[i] = conv_w[512 + c0 + i]; w2[i] = conv_w[1024 + c0 + i]; cb[i] = conv_b[c0 + i]; }
        float zp[8], zc[8], a[8], c[8];
        ld8(Pb + (size_t)(l0 - 1) * NP + c0, a); ld8(Pb + (size_t)(l0 - 1) * NP + 1024 + c0, c);
#pragma unroll
        for (int i = 0; i < 8; ++i) zp[i] = a[i] * c[i];
        ld8(Pb + (size_t)l0 * NP + c0, a); ld8(Pb + (size_t)l0 * NP + 1024 + c0, c);
#pragma unroll
        for (int i = 0; i < 8; ++i) zc[i] = a[i] * c[i];
        for (int t0 = 0; t0 < 32; t0 += 4) {
            v4u ra[4], rc[4], rb[4];
#pragma unroll
            for (int u = 0; u < 4; ++u) { const int l = l0 + t0 + u; const int ln = (l + 1 < LSEQ) ? l + 1 : l;
                ra[u] = *(const v4u*)(Pb + (size_t)ln * NP + c0); rc[u] = *(const v4u*)(Pb + (size_t)ln * NP + 1024 + c0); rb[u] = *(const v4u*)(Pb + (size_t)l * NP + 512 + c0); }
#pragma unroll
            for (int u = 0; u < 4; ++u) { const int l = l0 + t0 + u; const float vn = (l + 1 < LSEQ) ? 1.f : 0.f;
                const unsigned aw[4] = {ra[u].x, ra[u].y, ra[u].z, ra[u].w}, cw[4] = {rc[u].x, rc[u].y, rc[u].z, rc[u].w}, bw[4] = {rb[u].x, rb[u].y, rb[u].z, rb[u].w};
                float y[8];
#pragma unroll
                for (int i = 0; i < 4; ++i) {
                    const float zn0 = bflo(aw[i]) * bflo(cw[i]) * vn, zn1 = bfhi(aw[i]) * bfhi(cw[i]) * vn;
                    y[2 * i] = bflo(bw[i]) * (w0[2 * i] * zp[2 * i] + w1[2 * i] * zc[2 * i] + w2[2 * i] * zn0 + cb[2 * i]);
                    y[2 * i + 1] = bfhi(bw[i]) * (w0[2 * i + 1] * zp[2 * i + 1] + w1[2 * i + 1] * zc[2 * i + 1] + w2[2 * i + 1] * zn1 + cb[2 * i + 1]);
                    zp[2 * i] = zc[2 * i]; zc[2 * i] = zn0; zp[2 * i + 1] = zc[2 * i + 1]; zc[2 * i + 1] = zn1; }
                st8(Y + (size_t)(r_start + t0 + u) * D + c0, y); }
        }
    } else {
        const int c0 = (cgp - 64) * 8, g = c0 >> 7, hw = 1 << g;
        const bf16* Hb = Pb + 1536 + c0;
        float S[8], v[8];
#pragma unroll
        for (int i = 0; i < 8; ++i) S[i] = 0.f;
        { const int hi0 = (l0 + hw < LSEQ) ? l0 + hw : LSEQ;
          for (int j = l0 - hw; j < hi0; ++j) { ld8(Hb + (size_t)j * NP, v);
#pragma unroll
              for (int i = 0; i < 8; ++i) S[i] += v[i]; } }
        for (int t0 = 0; t0 < 32; t0 += 4) {
            v4u rc[4], rl[4], rh[4];
#pragma unroll
            for (int u = 0; u < 4; ++u) { const int l = l0 + t0 + u; const int lh = (l + hw < LSEQ) ? l + hw : l;
                rc[u] = *(const v4u*)(Hb + (size_t)l * NP); rl[u] = *(const v4u*)(Hb + (size_t)(l - hw) * NP); rh[u] = *(const v4u*)(Hb + (size_t)lh * NP); }
#pragma unroll
            for (int u = 0; u < 4; ++u) { const int l = l0 + t0 + u; const int hi = (l + hw < LSEQ) ? l + hw : LSEQ; const float inv = 1.0f / (float)(hi - (l - hw)); const float vh = (l + hw < LSEQ) ? 1.f : 0.f;
                const unsigned cw[4] = {rc[u].x, rc[u].y, rc[u].z, rc[u].w}, lw[4] = {rl[u].x, rl[u].y, rl[u].z, rl[u].w}, hwd[4] = {rh[u].x, rh[u].y, rh[u].z, rh[u].w};
                float m[8];
#pragma unroll
                for (int i = 0; i < 4; ++i) {
                    m[2 * i] = S[2 * i] * inv - bflo(cw[i]); m[2 * i + 1] = S[2 * i + 1] * inv - bfhi(cw[i]);
                    S[2 * i] += bflo(hwd[i]) * vh - bflo(lw[i]); S[2 * i + 1] += bfhi(hwd[i]) * vh - bfhi(lw[i]); }
                st8(Y + (size_t)(r_start + t0 + u) * D + 512 + c0, m); }
        }
    }
}

#define MFMA32(a, b, c) __builtin_amdgcn_mfma_f32_32x32x16_bf16((a), (b), (c), 0, 0, 0)
__device__ __forceinline__ float mkcand(float a, float b, unsigned tag) { return __builtin_bit_cast(float, (__builtin_bit_cast(unsigned, a + b) & ~0xFFu) | tag); }
__device__ __forceinline__ unsigned keylook(unsigned long long lo, unsigned long long hi, unsigned i) {
    const unsigned long long w = (i < 8u) ? lo : hi;
    return (unsigned)(w >> (8u * (i & 7u))) & 127u;
}
#define CE_DESC(a, b) do { const float hi_ = fmaxf((a), (b)), lo_ = fminf((a), (b)); (a) = hi_; (b) = lo_; } while (0)
__device__ __forceinline__ void sort16_desc(float (&v)[16]) {
    CE_DESC(v[0], v[13]); CE_DESC(v[1], v[12]); CE_DESC(v[2], v[15]); CE_DESC(v[3], v[14]); CE_DESC(v[4], v[8]); CE_DESC(v[5], v[6]); CE_DESC(v[7], v[11]); CE_DESC(v[9], v[10]);
    CE_DESC(v[0], v[5]); CE_DESC(v[1], v[7]); CE_DESC(v[2], v[9]); CE_DESC(v[3], v[4]); CE_DESC(v[6], v[13]); CE_DESC(v[8], v[14]); CE_DESC(v[10], v[15]); CE_DESC(v[11], v[12]);
    CE_DESC(v[0], v[1]); CE_DESC(v[2], v[3]); CE_DESC(v[4], v[5]); CE_DESC(v[6], v[8]); CE_DESC(v[7], v[9]); CE_DESC(v[10], v[11]); CE_DESC(v[12], v[13]); CE_DESC(v[14], v[15]);
    CE_DESC(v[0], v[2]); CE_DESC(v[1], v[3]); CE_DESC(v[4], v[10]); CE_DESC(v[5], v[11]); CE_DESC(v[6], v[7]); CE_DESC(v[8], v[9]); CE_DESC(v[12], v[14]); CE_DESC(v[13], v[15]);
    CE_DESC(v[1], v[2]); CE_DESC(v[3], v[12]); CE_DESC(v[4], v[6]); CE_DESC(v[5], v[7]); CE_DESC(v[8], v[10]); CE_DESC(v[9], v[11]); CE_DESC(v[13], v[14]);
    CE_DESC(v[1], v[4]); CE_DESC(v[2], v[6]); CE_DESC(v[5], v[8]); CE_DESC(v[7], v[10]); CE_DESC(v[9], v[13]); CE_DESC(v[11], v[14]);
    CE_DESC(v[2], v[4]); CE_DESC(v[3], v[6]); CE_DESC(v[9], v[12]); CE_DESC(v[11], v[13]);
    CE_DESC(v[3], v[5]); CE_DESC(v[6], v[8]); CE_DESC(v[7], v[9]); CE_DESC(v[10], v[12]);
    CE_DESC(v[3], v[4]); CE_DESC(v[5], v[6]); CE_DESC(v[7], v[8]); CE_DESC(v[9], v[10]); CE_DESC(v[11], v[12]);
    CE_DESC(v[6], v[7]); CE_DESC(v[8], v[9]);
}
__device__ __forceinline__ void merge16_desc(float (&t)[16], const float (&o)[16]) {
#pragma unroll
    for (int i = 0; i < 16; ++i) t[i] = fmaxf(t[i], o[15 - i]);
#pragma unroll
    for (int j = 8; j > 0; j >>= 1)
#pragma unroll
        for (int i = 0; i < 16; ++i) { const int l = i ^ j; if (l > i) CE_DESC(t[i], t[l]); }
}
__device__ __forceinline__ void p5_qdma(const bf16* Q, LAS unsigned char* ql, int tg, int hp, int lane) {
    int lo_ = lane; asm volatile("" : "+v"(lo_));
    const int lq = lo_ >> 4, base_l = lq * (NQ * 2) + (((lo_ & 15) ^ lq) << 4);
    const char* qb = (const char*)Q + ((size_t)tg * 32 * NQ + hp * 128) * 2;
#pragma unroll
    for (int i = 0; i < 8; ++i)
        __builtin_amdgcn_global_load_lds((const unsigned*)(qb + (size_t)i * (4 * NQ * 2) + (base_l ^ (((4 * i) & 15) << 4))), (LAS unsigned*)(ql + i * 1024), 16, 0, 0);
}
__device__ __forceinline__ void p5_item(const bf16* Q, const LAS unsigned char* kl, LAS unsigned char* ql, int* SI, float* SG, int tg, int tg_next, int head, int lane) {
    const int r = lane & 31, h = lane >> 5;
    const int tok = tg * 32 + r;
    const float NEG = -__builtin_inff();
    float sv[2][16];
#pragma unroll
    for (int p = 0; p < 2; ++p) {
        const int hp = head * 2 + p;
        f32x16 acc[4];
#pragma unroll
        for (int kt = 0; kt < 4; ++kt)
#pragma unroll
            for (int i = 0; i < 16; ++i) acc[kt][i] = 0.f;
        asm volatile("s_waitcnt vmcnt(0)" ::: "memory");
        __builtin_amdgcn_sched_barrier(0);
        const LAS unsigned char* kp = kl + p * 32768 + r * 256;
        const LAS unsigned char* qp = ql + r * 256;
#pragma unroll
        for (int s = 0; s < 8; ++s) {
            const int co = ((2 * s + h) ^ (r & 15)) << 4;
            const bf16x8 bq = *(const LAS bf16x8*)(qp + co);
#pragma unroll
            for (int kt = 0; kt < 4; ++kt) { const bf16x8 ak = *(const LAS bf16x8*)(kp + kt * 8192 + co); acc[kt] = MFMA32(ak, bq, acc[kt]); }
        }
        __builtin_amdgcn_sched_barrier(0);
        if (p == 0) p5_qdma(Q, ql, tg, hp + 1, lane); else if (tg_next >= 0) p5_qdma(Q, ql, tg_next, head * 2, lane);
        __builtin_amdgcn_sched_barrier(0);
        float t[16];
#pragma unroll
        for (int kt = 0; kt < 4; ++kt) {
            float g[16];
#pragma unroll
            for (int i = 0; i < 16; ++i) { const unsigned key = 32u * kt + (i & 3) + 8u * (i >> 2) + 4u * h;
                const float av = acc[kt][i];
                g[i] = __builtin_bit_cast(float, (__builtin_bit_cast(unsigned, av) & ~127u) | key); }
            sort16_desc(g);
            if (kt == 0) {
#pragma unroll
                for (int i = 0; i < 16; ++i) t[i] = g[i];
            } else merge16_desc(t, g);
        }
        float o[16];
#pragma unroll
        for (int i = 0; i < 16; ++i) o[i] = __shfl_xor(t[i], 32);
        merge16_desc(t, o);
#pragma unroll
        for (int i = 0; i < 16; ++i) sv[p][i] = t[i];
        __builtin_amdgcn_sched_barrier(0);
    }
    unsigned long long K0lo = 0ull, K0hi = 0ull, K1lo = 0ull, K1hi = 0ull;
#pragma unroll
    for (int i = 0; i < 8; ++i) {
        K0lo |= (unsigned long long)(__builtin_bit_cast(unsigned, sv[0][i]) & 127u) << (8 * i); K0hi |= (unsigned long long)(__builtin_bit_cast(unsigned, sv[0][8 + i]) & 127u) << (8 * i);
        K1lo |= (unsigned long long)(__builtin_bit_cast(unsigned, sv[1][i]) & 127u) << (8 * i); K1hi |= (unsigned long long)(__builtin_bit_cast(unsigned, sv[1][8 + i]) & 127u) << (8 * i); }
    float sel[16];
    {
        float ca[16], cb[16];
        ca[0] = h ? mkcand(sv[0][1], sv[1][0], 16u) : mkcand(sv[0][0], sv[1][0], 0u);
        ca[1] = h ? mkcand(sv[0][2], sv[1][0], 32u) : mkcand(sv[0][0], sv[1][1], 1u);
        ca[2] = h ? mkcand(sv[0][3], sv[1][0], 48u) : mkcand(sv[0][0], sv[1][2], 2u);
        ca[3] = h ? mkcand(sv[0][4], sv[1][0], 64u) : mkcand(sv[0][0], sv[1][3], 3u);
        ca[4] = h ? mkcand(sv[0][5], sv[1][0], 80u) : mkcand(sv[0][0], sv[1][4], 4u);
        ca[5] = h ? mkcand(sv[0][6], sv[1][0], 96u) : mkcand(sv[0][0], sv[1][5], 5u);
        ca[6] = h ? mkcand(sv[0][7], sv[1][0], 112u) : mkcand(sv[0][0], sv[1][6], 6u);
        ca[7] = h ? mkcand(sv[0][8], sv[1][0], 128u) : mkcand(sv[0][0], sv[1][7], 7u);
        ca[8] = h ? mkcand(sv[0][9], sv[1][0], 144u) : mkcand(sv[0][0], sv[1][8], 8u);
        ca[9] = h ? mkcand(sv[0][10], sv[1][0], 160u) : mkcand(sv[0][0], sv[1][9], 9u);
        ca[10] = h ? mkcand(sv[0][11], sv[1][0], 176u) : mkcand(sv[0][0], sv[1][10], 10u);
        ca[11] = h ? mkcand(sv[0][12], sv[1][0], 192u) : mkcand(sv[0][0], sv[1][11], 11u);
        ca[12] = h ? mkcand(sv[0][13], sv[1][0], 208u) : mkcand(sv[0][0], sv[1][12], 12u);
        ca[13] = h ? mkcand(sv[0][14], sv[1][0], 224u) : mkcand(sv[0][0], sv[1][13], 13u);
        ca[14] = h ? mkcand(sv[0][15], sv[1][0], 240u) : mkcand(sv[0][0], sv[1][14], 14u);
        ca[15] = h ? NEG : mkcand(sv[0][0], sv[1][15], 15u);
        cb[0] = h ? mkcand(sv[0][1], sv[1][2], 18u) : mkcand(sv[0][1], sv[1][1], 17u);
        cb[1] = h ? mkcand(sv[0][1], sv[1][4], 20u) : mkcand(sv[0][1], sv[1][3], 19u);
        cb[2] = h ? mkcand(sv[0][1], sv[1][6], 22u) : mkcand(sv[0][1], sv[1][5], 21u);
        cb[3] = h ? mkcand(sv[0][2], sv[1][1], 33u) : mkcand(sv[0][1], sv[1][7], 23u);
        cb[4] = h ? mkcand(sv[0][2], sv[1][3], 35u) : mkcand(sv[0][2], sv[1][2], 34u);
        cb[5] = h ? mkcand(sv[0][3], sv[1][1], 49u) : mkcand(sv[0][2], sv[1][4], 36u);
        cb[6] = h ? mkcand(sv[0][3], sv[1][3], 51u) : mkcand(sv[0][3], sv[1][2], 50u);
        cb[7] = h ? mkcand(sv[0][4], sv[1][2], 66u) : mkcand(sv[0][4], sv[1][1], 65u);
        cb[8] = h ? mkcand(sv[0][6], sv[1][1], 97u) : mkcand(sv[0][5], sv[1][1], 81u);
        cb[9] = h ? NEG : mkcand(sv[0][7], sv[1][1], 113u);
        cb[10] = NEG;
        cb[11] = NEG;
        cb[12] = NEG;
        cb[13] = NEG;
        cb[14] = NEG;
        cb[15] = NEG;
        sort16_desc(cb); merge16_desc(ca, cb);
        float co[16];
#pragma unroll
        for (int i = 0; i < 16; ++i) co[i] = __shfl_xor(ca[i], 32);
        merge16_desc(ca, co);
#pragma unroll
        for (int i = 0; i < 16; ++i) sel[i] = ca[i];
    }
    float e[16], esum = 0.f; int eidx[16];
#pragma unroll
    for (int t = 0; t < 16; ++t) { e[t] = __expf(sel[t] - sel[0]); esum += e[t];
        const unsigned tag = __builtin_bit_cast(unsigned, sel[t]) & 0xFFu;
        eidx[t] = (int)(keylook(K0lo, K0hi, tag >> 4) * 128u + keylook(K1lo, K1hi, tag & 15u)); }
    const float inv = 1.0f / esum;
    if (h == 0) { int* o = SI + (size_t)tok * 128 + head * 16;
#pragma unroll
        for (int t = 0; t < 16; t += 4) *(int4*)(o + t) = make_int4(eidx[t], eidx[t + 1], eidx[t + 2], eidx[t + 3]); }
    else { float* o = SG + (size_t)tok * 128 + head * 16;
#pragma unroll
        for (int t = 0; t < 16; t += 4) *(f32x4*)(o + t) = (f32x4){e[t] * inv, e[t + 1] * inv, e[t + 2] * inv, e[t + 3] * inv}; }
}

__device__ __forceinline__ void p5_block(const bf16* Q, const bf16* KB, int* SI, float* SG, LAS unsigned char* lds, int vb, int tid, const float* pu, const float* pv, const float* g2, unsigned char* U8, unsigned char* V8, int G) {
    const int head = vb & 7, wave = tid >> 6, lane = tid & 63;
    __syncthreads();
#pragma unroll
    for (int i = 0; i < 8; ++i) { const int cid = tid + 512 * i, hpl = cid >> 11, row = (cid >> 4) & 127, c = cid & 15;
        const v4u val = *(const v4u*)(KB + ((size_t)(head * 2 + hpl) * 128 + row) * 128 + c * 8);
        *(LAS v4u*)(lds + hpl * 32768 + row * 256 + ((c ^ (row & 15)) << 4)) = val; }
    __syncthreads();
    LAS unsigned char* ql = lds + 65536 + wave * 8192;
    const int NGW = 256 * NWAVES, gwv = vb * NWAVES + wave;
    p5_qdma(Q, ql, (vb >> 3) + 32 * wave, head * 2, lane);
    for (int n = 0; n < 4; ++n) {
        { const int m = gwv + 2 * n * NGW;
          p5_item(Q, lds, ql, SI, SG, (vb >> 3) + 32 * (wave + 8 * n), (n + 1 < 4) ? (vb >> 3) + 32 * (wave + 8 * (n + 1)) : -1, head, lane);
          __builtin_amdgcn_sched_barrier(0);
          f32x4 va[4], vb_[4], vc[4], vd[4];
          row_load(pu + (size_t)m * D, va, lane); row_load(pu + (size_t)(m + NGW) * D, vb_, lane); row_load(pv + (size_t)m * D, vc, lane); row_load(pv + (size_t)(m + NGW) * D, vd, lane);
          { f32x4 gv_[4];
#pragma unroll
            for (int j = 0; j < 4; ++j) gv_[j] = ((const f32x4*)g2)[lane + 64 * j];
            row_store_fp8(va, U8 + (size_t)m * D, gv_, U8_SCALE, lane); row_store_fp8(vb_, U8 + (size_t)(m + NGW) * D, gv_, U8_SCALE, lane);
#pragma unroll
            for (int j = 0; j < 4; ++j) gv_[j] = (f32x4){1.f, 1.f, 1.f, 1.f};
            row_store_fp8(vc, V8 + (size_t)m * D, gv_, V8_SCALE, lane); row_store_fp8(vd, V8 + (size_t)(m + NGW) * D, gv_, V8_SCALE, lane); }
          __builtin_amdgcn_sched_barrier(0); }
    }
}

__device__ __forceinline__ f32x2 cvt8(unsigned w, bool hi) { return hi ? __builtin_amdgcn_cvt_pk_f32_fp8((int)w, true) : __builtin_amdgcn_cvt_pk_f32_fp8((int)w, false); }
#ifndef RED_SWAP
#define RED_SWAP 1
#define RED_DPP 1
#endif
typedef unsigned u32x2 __attribute__((ext_vector_type(2)));
typedef _Float16 h16x2 __attribute__((ext_vector_type(2)));
__device__ __forceinline__ float gelu_erf(float v) {
    const float av = __builtin_fabsf(v), t = __builtin_amdgcn_rcpf(av * 0.2316418882f + 1.0f);
    float q = t * 0.5307027145f + (-0.7265760135f); q = q * t + 0.7107068705f; q = q * t + (-0.142248368f); q = q * t + 0.127414796f; q = q * t;
    const float e = __builtin_amdgcn_exp2f((v * v) * (-0.72134752044f));
    const float m = v * (q * e);
    return v < 0.f ? m : v - m;
}
#define DPP_ADD(v, ctrl) ((v) + __builtin_bit_cast(float, __builtin_amdgcn_mov_dpp(__builtin_bit_cast(int, (v)), (ctrl), 0xF, 0xF, true)))
__device__ __forceinline__ float swap32_add(float a, float b) { const u32x2 r = __builtin_amdgcn_permlane32_swap(__builtin_bit_cast(unsigned, a), __builtin_bit_cast(unsigned, b), false, false);
    const unsigned r0 = r[0], r1 = r[1]; return __builtin_bit_cast(float, r0) + __builtin_bit_cast(float, r1); }
__device__ __forceinline__ float swap16_add(float a, float b) { const u32x2 r = __builtin_amdgcn_permlane16_swap(__builtin_bit_cast(unsigned, a), __builtin_bit_cast(unsigned, b), false, false);
    const unsigned r0 = r[0], r1 = r[1]; return __builtin_bit_cast(float, r0) + __builtin_bit_cast(float, r1); }
__device__ __forceinline__ void sort128(unsigned& k0, unsigned& k1, int lane) {
#pragma unroll
    for (int k = 1; k <= 7; ++k)
#pragma unroll
        for (int j = k - 1; j >= 0; --j) {
            if (j == 6) { const unsigned lo = k0 < k1 ? k0 : k1, hi = k0 < k1 ? k1 : k0; k0 = lo; k1 = hi; }
            else {
                const unsigned o0 = (unsigned)__shfl_xor((int)k0, 1 << j), o1 = (unsigned)__shfl_xor((int)k1, 1 << j);
                const bool lower = ((lane >> j) & 1) == 0;
                const bool up0 = (k == 7) ? true : ((k == 6) ? true : (((lane >> k) & 1) == 0));
                const bool up1 = (k == 7) ? true : ((k == 6) ? false : (((lane >> k) & 1) == 0));
                const unsigned mn0 = k0 < o0 ? k0 : o0, mx0 = k0 < o0 ? o0 : k0, mn1 = k1 < o1 ? k1 : o1, mx1 = k1 < o1 ? o1 : k1;
                k0 = (lower == up0) ? mn0 : mx0; k1 = (lower == up1) ? mn1 : mx1;
            }
        }
}
__device__ __forceinline__ void xcd_align(unsigned* cnt, unsigned nloc, unsigned& epoch) {
    __syncthreads();
    ++epoch;
    if (threadIdx.x == 0) {
        __hip_atomic_fetch_add(cnt, 1u, __ATOMIC_RELAXED, __HIP_MEMORY_SCOPE_AGENT);
        const unsigned target = nloc * epoch; unsigned sp = 0;
        while (__hip_atomic_load(cnt, __ATOMIC_RELAXED, __HIP_MEMORY_SCOPE_AGENT) < target && ++sp < (1u << 14)) __builtin_amdgcn_s_sleep(2);
    }
    __syncthreads();
}
constexpr int P6K = 4;
#define P6_ROWLOAD(TAB, J, B) do { _Pragma("unroll") for (int k = 0; k < 4; ++k) { const int e_ = 4 * (B) + k; \
        const int idx_ = __builtin_amdgcn_readlane(((B) < 16) ? idx0[J] : idx1[J], e_ & 63); \
        rows[J][k] = ((const v4u*)((TAB) + (size_t)idx_ * D))[lane]; } } while (0)
__device__ __forceinline__ void p6_round(const bf16* H2B, const unsigned long long* rowss, const int* SI, const float* SG, const unsigned char* U8, const unsigned char* V8, const float* gf, float* OUT,
                                         int tok0, int lane, LAS unsigned char* stg, int& pend_tok0, unsigned* xcnt, unsigned nloc, unsigned& epoch, unsigned long long (&pt)[6]) {
#ifdef PROBE_SEL
    unsigned long long t_a = __builtin_amdgcn_s_memrealtime(), t_b;
#define PT(i) do { t_b = __builtin_amdgcn_s_memrealtime(); pt[i] += t_b - t_a; t_a = t_b; } while (0)
#else
#define PT(i) do {} while (0)
#endif
    h16x2 xh[P6K][8]; int idx0[P6K], idx1[P6K]; float gs0[P6K], gs1[P6K], asc[P6K];
#pragma unroll
    for (int j = 0; j < P6K; ++j) { const int tok = tok0 + j;
        const v4u* hb = (const v4u*)(H2B + (size_t)tok * D) + 2 * lane;
        const v4u xa = hb[0], xb = hb[1];
        { const unsigned xw_[8] = {xa.x, xa.y, xa.z, xa.w, xb.x, xb.y, xb.z, xb.w};
#pragma unroll
          for (int q = 0; q < 8; ++q) xh[j][q] = (h16x2){(_Float16)bflo(xw_[q]), (_Float16)bfhi(xw_[q])}; }
        unsigned k0 = ((unsigned)SI[(size_t)tok * 128 + lane] << 7) | (unsigned)lane, k1 = ((unsigned)SI[(size_t)tok * 128 + 64 + lane] << 7) | (unsigned)(64 + lane);
        sort128(k0, k1, lane);
        idx0[j] = (int)(k0 >> 7); idx1[j] = (int)(k1 >> 7);
        gs0[j] = SG[(size_t)tok * 128 + (k0 & 127u)]; gs1[j] = SG[(size_t)tok * 128 + (k1 & 127u)];
        asc[j] = rsqrtf((float)rowss[tok] * (1.0f / (4294967296.0f * D)) + EPS) * (1.0f / U8_SCALE); }
    const int rw = lane >> 4;
#ifdef OLD_REDUCE
    const int kl = ((lane >> 5) & 1) + 2 * ((lane >> 4) & 1);
#else
    const int kl = ((rw & 1) << 1) | (rw >> 1);
#endif
    const int kl_unused_ = 0; (void)kl_unused_;
#ifdef OLD_REDUCE
    const int lh = 32 * (lane & 1) + 16 * ((lane >> 1) & 1);
#else
    const int lh = 16 * ((((lane & 3) & 1) << 1) | ((lane & 3) >> 1));
#endif
    float w0[P6K], w1[P6K];
#pragma unroll
    for (int j = 0; j < P6K; ++j) { w0[j] = 0.f; w1[j] = 0.f; }
    v4u rows[P6K][4];
    PT(0);
    if (epoch == 0u) xcd_align(xcnt, nloc, epoch); else __builtin_amdgcn_s_barrier();
    PT(1);
#pragma unroll
    for (int j = 0; j < P6K; ++j) P6_ROWLOAD(U8, j, 0);
    for (int b = 0; b < 32; ++b) {
        if ((b & 7) == 0) __builtin_amdgcn_s_barrier();
        if (pend_tok0 >= 0) {
            const v2u d_ = *(const LAS v2u*)(stg + b * 512 + lane * 8);
            *(v2u*)((char*)OUT + (size_t)pend_tok0 * (D * 4) + b * 512 + lane * 8) = d_; }
#pragma unroll
        for (int j = 0; j < P6K; ++j) {
            float d_[4];
#pragma unroll
            for (int k = 0; k < 4; ++k) { float a_ = 0.f; const unsigned uw_[4] = {rows[j][k].x, rows[j][k].y, rows[j][k].z, rows[j][k].w};
#pragma unroll
                for (int q = 0; q < 4; ++q) { a_ = __builtin_amdgcn_fdot2(__builtin_amdgcn_cvt_scalef32_pk_f16_fp8(uw_[q], 1.0f, false), xh[j][2 * q], a_, false);
                                              a_ = __builtin_amdgcn_fdot2(__builtin_amdgcn_cvt_scalef32_pk_f16_fp8(uw_[q], 1.0f, true), xh[j][2 * q + 1], a_, false); }
                d_[k] = a_; }
            if (b + 1 < 32) P6_ROWLOAD(U8, j, b + 1);
            float s_;
#if RED_SWAP == 1
            s_ = swap16_add(swap32_add(d_[0], d_[1]), swap32_add(d_[2], d_[3]));
#elif RED_SWAP == 2
            { const bool h4 = (lane & 16) != 0; const float r0_ = swap32_add(d_[0], d_[1]), r1_ = swap32_add(d_[2], d_[3]);
              const float a_ = h4 ? r1_ : r0_, b_ = h4 ? r0_ : r1_; s_ = a_ + __shfl_xor(b_, 16); }
#else
            { const bool h5 = (lane & 32) != 0, h4 = (lane & 16) != 0; float r_[2];
              for (int i = 0; i < 2; ++i) { const float a_ = h5 ? d_[2 * i + 1] : d_[2 * i], b_ = h5 ? d_[2 * i] : d_[2 * i + 1]; r_[i] = a_ + __shfl_xor(b_, 32); }
              { const float a_ = h4 ? r_[1] : r_[0], b_ = h4 ? r_[0] : r_[1]; s_ = a_ + __shfl_xor(b_, 16); } }
#endif
#if RED_DPP
            s_ = DPP_ADD(s_, 0x128); s_ = DPP_ADD(s_, 0x124); s_ = DPP_ADD(s_, 0x4E); s_ = DPP_ADD(s_, 0xB1);
#else
            s_ += __shfl_xor(s_, 8); s_ += __shfl_xor(s_, 4); s_ += __shfl_xor(s_, 2); s_ += __shfl_xor(s_, 1);
#endif
            const float wp_ = __shfl(s_, lh);
            const bool mine = (lane >> 2) == (b & 15);
            w0[j] = (mine && b < 16) ? wp_ : w0[j]; w1[j] = (mine && b >= 16) ? wp_ : w1[j];
        }
    }
#pragma unroll
    for (int j = 0; j < P6K; ++j) { w0[j] = gs0[j] * gelu_erf(w0[j] * asc[j]) * (1.0f / V8_SCALE); w1[j] = gs1[j] * gelu_erf(w1[j] * asc[j]) * (1.0f / V8_SCALE); }
    PT(2);
#ifdef ALIGN_V
    xcd_align(xcnt, nloc, epoch);
#else
    __builtin_amdgcn_s_barrier();
#endif
    PT(3);
    f32x2 o2[P6K][8];
#pragma unroll
    for (int j = 0; j < P6K; ++j) {
#pragma unroll
        for (int q = 0; q < 8; ++q) o2[j][q] = (f32x2){0.f, 0.f};
        P6_ROWLOAD(V8, j, 0); }
    for (int b = 0; b < 32; ++b) {
        if ((b & 7) == 0) __builtin_amdgcn_s_barrier();
#pragma unroll
        for (int j = 0; j < P6K; ++j) {
#pragma unroll
            for (int k = 0; k < 4; ++k) { const float w_ = __builtin_bit_cast(float, __builtin_amdgcn_readlane(__builtin_bit_cast(int, (b < 16) ? w0[j] : w1[j]), (4 * b + k) & 63));
                const unsigned vw_[4] = {rows[j][k].x, rows[j][k].y, rows[j][k].z, rows[j][k].w};
#pragma unroll
                for (int q = 0; q < 4; ++q) { o2[j][2 * q] = cvt8(vw_[q], false) * w_ + o2[j][2 * q]; o2[j][2 * q + 1] = cvt8(vw_[q], true) * w_ + o2[j][2 * q + 1]; } }
            if (b + 1 < 32) P6_ROWLOAD(V8, j, b + 1);
        }
    }
    PT(4);
    const f32x4* gp = (const f32x4*)gf + 4 * lane;
#pragma unroll
    for (int j = 0; j < P6K; ++j) {
        f32x4* op = (f32x4*)(OUT + (size_t)(tok0 + j) * D) + 4 * lane;
        const v4u* hb = (const v4u*)(H2B + (size_t)(tok0 + j) * D) + 2 * lane;
        const v4u ha = hb[0], hc = hb[1];
        const unsigned hw[8] = {ha.x, ha.y, ha.z, ha.w, hc.x, hc.y, hc.z, hc.w};
        f32x4 y[4]; float ss = 0.f;
#pragma unroll
        for (int q = 0; q < 4; ++q) { y[q] = (f32x4){bflo(hw[2 * q]) + o2[j][2 * q].x, bfhi(hw[2 * q]) + o2[j][2 * q].y, bflo(hw[2 * q + 1]) + o2[j][2 * q + 1].x, bfhi(hw[2 * q + 1]) + o2[j][2 * q + 1].y};
            ss += (y[q].x * y[q].x + y[q].y * y[q].y) + (y[q].z * y[q].z + y[q].w * y[q].w); }
        ss = wave_sum(ss);
        const float rs = rsqrtf(ss * (1.0f / D) + EPS);
#pragma unroll
        for (int q = 0; q < 4; ++q) *(LAS f32x4*)(stg + j * 4096 + lane * 64 + q * 16) = y[q] * rs * gp[q];
        (void)op;
    }
    pend_tok0 = tok0;
    PT(5);
}

struct Args { const float* in[15]; float* out; unsigned char* ws; int ph_lo, ph_hi; };
constexpr int NPHASE = 7;
#ifndef MK_N_LAUNCHES
#define MK_N_LAUNCHES 1
#endif

__global__ void __launch_bounds__(NWAVES * 64, 2) fwd_kernel(Args args) {
    extern __shared__ __attribute__((aligned(16))) unsigned char lds_raw[];
    LAS unsigned char* lds = (LAS unsigned char*)lds_raw;
    volatile LAS unsigned* MISC = (volatile LAS unsigned*)(lds + MISC_OFF);
    const int tid = threadIdx.x, lane = tid & 63, wave = __builtin_amdgcn_readfirstlane(tid >> 6);
    const int G = gridDim.x, blk = blockIdx.x;
    unsigned char* ws = args.ws;
    const float* x = args.in[0]; const float* meta = args.in[1]; const float* g1 = args.in[2]; const float* w_in = args.in[3];
    const float* conv_w = args.in[4]; const float* conv_b = args.in[5]; const float* pool_w = args.in[6]; const float* pool_scale = args.in[7];
    const float* w_out = args.in[8]; const float* g2 = args.in[9]; const float* w_q = args.in[10]; const float* keys = args.in[11];
    const float* pu = args.in[12]; const float* pv = args.in[13]; const float* gf = args.in[14];
    bf16* WinT = (bf16*)(ws + WS_WIN); bf16* WoutT = (bf16*)(ws + WS_WOUT); bf16* WqT = (bf16*)(ws + WS_WQ); bf16* KB = (bf16*)(ws + WS_KEYS);
    float* rstd1 = (float*)(ws + WS_RSTD1); unsigned long long* rowss = (unsigned long long*)(ws + WS_ROWSS);
    unsigned char* U8 = ws + WS_UB; unsigned char* V8 = ws + WS_VB; bf16* XB = (bf16*)(ws + WS_XB); bf16* YP = (bf16*)(ws + WS_XB);
    bf16* P = (bf16*)(ws + WS_P); bf16* Qb = (bf16*)(ws + WS_P); bf16* H2B = (bf16*)(ws + WS_H2B);
    int* SI = (int*)(ws + WS_SELI); float* SG = (float*)(ws + WS_SELG);

    for (int u = tid; u < (LDS_BYTES - RING_BYTES) / 4; u += NWAVES * 64) ((LAS unsigned*)(lds + RING_BYTES))[u] = 0u;
    __syncthreads();
    const int lo = args.ph_lo, hi = args.ph_hi;
#if defined(PROBE_SEL) && PROBE_SEL == 9
    if (tid == 0) atomicMax((unsigned long long*)(ws + WS_CTL + 64), ~(unsigned long long)__builtin_amdgcn_s_memrealtime());
#endif
#ifdef PROBE_SEL
    const unsigned long long t_kstart = __builtin_amdgcn_s_memrealtime(); unsigned long long t_p6start = 0ull; unsigned long long tsp[8]; tsp[0] = t_kstart;
#define TSP(i) tsp[i] = __builtin_amdgcn_s_memrealtime()
#else
#define TSP(i) do {} while (0)
#endif
    XcdBarrier bar; bar.bar = (unsigned*)(ws + WS_CTL) + CW_BAR; bar.x = 0; bar.st = nullptr;
    if (hi - lo > 1) bar = xcd_barrier_post((unsigned*)(ws + WS_CTL) + CW_BAR, MISC + 8);
#define IN(k) (lo <= (k) && (k) < hi)
#define SEAM(k) do { if (IN(k) && IN((k) + 1)) xcd_barrier(bar); } while (0)
    const int gw = blk * NWAVES + wave, NGW = G * NWAVES;

    if (IN(0)) {
        LAS float* scr = (LAS float*)(lds + wave * 16384);
        for (int it = gw; it < 1024 + 1024 + 256 + 1024; it += NGW) {
            int r = __builtin_amdgcn_readfirstlane(it);
            if (r < 1024) { p0_transpose_item(w_in, D, NP, g1, WinT, scr, r, lane); continue; } r -= 1024;
            if (r < 1024) { p0_transpose_item(w_q, D, NQ, g2, WqT, scr, r, lane); continue; } r -= 1024;
            if (r < 256) { p0_transpose_item(w_out, D, D, nullptr, WoutT, scr, r, lane); continue; } r -= 256;
            p0_weff_item(w_out, pool_w, pool_scale, WoutT, r, lane);
        }
        for (int m = gw; m < T; m += 4 * NGW) {
            f32x4 va[4], vb[4], vc[4], vd[4];
            row_load(x + (size_t)m * D, va, lane); row_load(x + (size_t)(m + NGW) * D, vb, lane); row_load(x + (size_t)(m + 2 * NGW) * D, vc, lane); row_load(x + (size_t)(m + 3 * NGW) * D, vd, lane);
            row_store_bf16(va, XB + (size_t)m * D, rstd1 + m, lane); row_store_bf16(vb, XB + (size_t)(m + NGW) * D, rstd1 + m + NGW, lane);
            row_store_bf16(vc, XB + (size_t)(m + 2 * NGW) * D, rstd1 + m + 2 * NGW, lane); row_store_bf16(vd, XB + (size_t)(m + 3 * NGW) * D, rstd1 + m + 3 * NGW, lane);
        }
        for (int m = gw; m < 256; m += NGW) row_to_bf16(keys + (size_t)m * D, KB + (size_t)m * D, nullptr, nullptr, lane);
    }
    SEAM(0); TSP(1);
    if (IN(1)) {
        for (int mb = blk; mb < 256; mb += G) p1_meta(meta, WinT, P, lds, mb, tid);
        pg8::Gemm g{XB, WinT, T, NP, D}; pg8::StaticOrder S; S.init(T, NP, G, blk);
        EpiP E{P, rstd1};
        pg8::gemm_phase<EpiP, pg8::StaticOrder, true, true>(lds, g, S, E);
    }
    SEAM(1); TSP(2);
    if (IN(2)) {
        for (int b2 = blk; b2 < T / 128; b2 += G) p2_convpool(P, conv_w, conv_b, YP, b2, tid);
    }
    SEAM(2); TSP(3);
    if (IN(3)) {
        pg8::Gemm g{YP, WoutT, T, D, D}; pg8::StaticOrder S; S.init(T, D, G, blk);
        EpiH2 E{x, H2B, rowss};
        pg8::gemm_phase<EpiH2, pg8::StaticOrder, true, true>(lds, g, S, E);
    }
    SEAM(3); TSP(4);
    if (IN(4)) {
        pg8::Gemm g{H2B, WqT, T, NQ, D}; pg8::StaticOrder S; S.init(T, NQ, G, blk);
        EpiQ E{Qb, rowss};
        pg8::gemm_phase<EpiQ, pg8::StaticOrder, true, true>(lds, g, S, E);
    }
    SEAM(4); TSP(5);
    if (IN(5)) {
        for (int vb = blk; vb < 256; vb += G) p5_block(Qb, KB, SI, SG, lds, vb, tid, pu, pv, g2, U8, V8, G);
    }
    SEAM(5); TSP(6);
    if (IN(6)) {
#ifdef PROBE_SEL
        t_p6start = __builtin_amdgcn_s_memrealtime();
#endif
        unsigned epoch = 0u; const unsigned nloc = MISC[8] ? MISC[8] : (unsigned)(G / 8);
        unsigned* xcnt = (unsigned*)(ws + WS_CTL) + CW_XS + 64 * xb_xcc_id();
        unsigned long long pt[6] = {0ull, 0ull, 0ull, 0ull, 0ull, 0ull};
        LAS unsigned char* stg = lds + wave * 16384;
        int pend_tok0 = -1;
        for (int t0 = gw * P6K; t0 < T; t0 += NGW * P6K) p6_round(H2B, rowss, SI, SG, U8, V8, gf, args.out, t0, lane, stg, pend_tok0, xcnt, nloc, epoch, pt);
        if (pend_tok0 >= 0) {
#pragma unroll 4
            for (int b = 0; b < 16; ++b) { const v4u d_ = *(const LAS v4u*)(stg + b * 1024 + lane * 16);
                *(v4u*)((char*)args.out + (size_t)pend_tok0 * (D * 4) + b * 1024 + lane * 16) = d_; } }
#if defined(PROBE_SEL) && PROBE_SEL != 9
        if (gw == 0 && lane == 0) { asm volatile("s_waitcnt vmcnt(0)" ::: "memory");
            const unsigned long long tend = __builtin_amdgcn_s_memrealtime();
            tsp[7] = tend;
            float us = (PROBE_SEL < 6) ? (float)pt[PROBE_SEL < 6 ? PROBE_SEL : 0] * 0.01f : ((PROBE_SEL == 6) ? (float)(tend - t_p6start) * 0.01f : ((PROBE_SEL == 7) ? (float)(tend - t_kstart) * 0.01f : (float)(tsp[(PROBE_SEL >= 10 ? PROBE_SEL - 10 : 0) + 1] - tsp[PROBE_SEL >= 10 ? PROBE_SEL - 10 : 0]) * 0.01f));
            args.out[0] = 2.0f + ((PROBE_SEL == 7) ? (us - 900.0f) : us) * 0.01f; }
#endif
    }
#if defined(PROBE_SEL) && PROBE_SEL == 9
    asm volatile("s_waitcnt vmcnt(0)" ::: "memory");
    if (tid == 0) atomicMax((unsigned long long*)(ws + WS_CTL + 72), (unsigned long long)__builtin_amdgcn_s_memrealtime());
    xcd_barrier(bar);
    if (blk == 0 && tid == 0) { const unsigned long long a = ~__hip_atomic_load((unsigned long long*)(ws + WS_CTL + 64), __ATOMIC_RELAXED, __HIP_MEMORY_SCOPE_AGENT), b = __hip_atomic_load((unsigned long long*)(ws + WS_CTL + 72), __ATOMIC_RELAXED, __HIP_MEMORY_SCOPE_AGENT);
        args.out[0] = 2.0f + ((float)(b - a) * 0.01f - 900.0f) * 0.01f; }
#endif
#undef IN
#undef SEAM
}

extern "C" void kernel_launch(void* const* d_in, const int* in_sizes, int n_in, void* d_out, int out_size, void* d_ws, size_t ws_size, hipStream_t stream) {
    static int grid = 0;
    if (grid == 0) {
        if (n_in != 15 || out_size != T * D || ws_size < WS_END) { fprintf(stderr, "kernel_launch: unexpected shapes: n_in %d out %d ws %zu (need %zu)\n", n_in, out_size, ws_size, (size_t)WS_END); grid = -1; return; }
        int dev = 0, cus = 0, per_cu = 0;
        if (hipGetDevice(&dev) != hipSuccess || hipDeviceGetAttribute(&cus, hipDeviceAttributeMultiprocessorCount, dev) != hipSuccess) { grid = -1; return; }
        if (hipFuncSetAttribute((const void*)fwd_kernel, hipFuncAttributeMaxDynamicSharedMemorySize, LDS_BYTES) != hipSuccess) { fprintf(stderr, "kernel_launch: hipFuncSetAttribute failed\n"); grid = -1; return; }
        if (hipOccupancyMaxActiveBlocksPerMultiprocessor(&per_cu, (const void*)fwd_kernel, NWAVES * 64, LDS_BYTES) != hipSuccess || per_cu < 1) fprintf(stderr, "kernel_launch: occupancy query says %d\n", per_cu);
        (void)hipGetLastError();
        grid = cus;
        if (grid != 256) { fprintf(stderr, "kernel_launch: built for a 256-CU device (work is dealt to 256 workgroups x 8 waves); found %d CUs\n", cus); grid = -1; return; }
    }
    if (grid < 0) return;
    (void)hipMemsetAsync((char*)d_ws + WS_CTL, 0, CTL_ZERO_BYTES, stream);
    Args a{};
    for (int i = 0; i < 15; ++i) a.in[i] = (const float*)d_in[i];
    a.out = (float*)d_out; a.ws = (unsigned char*)d_ws;
#if MK_N_LAUNCHES == 1
    a.ph_lo = 0; a.ph_hi = NPHASE;
    hipLaunchKernelGGL(fwd_kernel, dim3(grid), dim3(NWAVES * 64), LDS_BYTES, stream, a);
#else
    for (int li = 0; li < NPHASE; ++li) { a.ph_lo = li; a.ph_hi = li + 1;
        hipLaunchKernelGGL(fwd_kernel, dim3(grid), dim3(NWAVES * 64), LDS_BYTES, stream, a); }
#endif
}
```
